# Optimizing an MI355X kernel written in HIP

```python
import math
import jax
import jax.numpy as jnp
from jax import lax
import numpy as np

D_MODEL = 2048
BATCH = 8
SEQ = 2048
DEPTH = 2

HEAD_DIM = 128
Q_BLOCK = 128
A_GROUPS = ((128, 1), (512, 4), (2048, 16))
A_HEADS_PER_GROUP = 2
A_HEADS = A_HEADS_PER_GROUP * len(A_GROUPS)
A_OUT = A_HEADS_PER_GROUP * HEAD_DIM
B_HEADS = 4
CMP_LEN = 32
CMP_STRIDE = 16
SLC_LEN = 64
N_SELECT = 16
WIN = 512
B_OUT = B_HEADS * HEAD_DIM
C_HEADS = 6
C_OUT = C_HEADS * HEAD_DIM
N_BUCKETS = 32
MAX_DISTANCE = 2048
BIAS_HEADS = A_HEADS + B_HEADS
D_FF = 5632
CONV_W = 3
ALPHA = (2 * DEPTH) ** 0.25
BETA = (8 * DEPTH) ** -0.25
LN_EPS = 1e-5
NEG_INF = -1e30
FORCE_SCORE = 1e9
ATTN_SCALE = HEAD_DIM ** -0.5

IN_SPLITS = (
    ('a_q', A_HEADS * HEAD_DIM), ('a_k', A_HEADS * HEAD_DIM), ('a_v', A_HEADS * HEAD_DIM),
    ('b_q', B_HEADS * HEAD_DIM),
    ('b_k_cmp', HEAD_DIM), ('b_v_cmp', HEAD_DIM),
    ('b_k_slc', HEAD_DIM), ('b_v_slc', HEAD_DIM),
    ('b_k_win', HEAD_DIM), ('b_v_win', HEAD_DIM),
    ('b_gate', 3 * B_HEADS),
    ('c_q', C_HEADS * HEAD_DIM), ('c_k', C_HEADS * HEAD_DIM), ('c_v', C_HEADS * HEAD_DIM),
    ('c_f', C_HEADS),
)
V_COLUMNS = ('a_v', 'b_v_cmp', 'b_v_slc', 'b_v_win', 'c_v')
N_IN = sum(w for _, w in IN_SPLITS)

kernel_name = 'hybrid_gated_dilated_nsa_fox_block'


def t5_bucket(dist):
    max_exact = N_BUCKETS // 2
    d = jnp.maximum(dist, 0)
    log_ratio = jnp.log(jnp.maximum(d, 1).astype(jnp.float32) / max_exact) / math.log(MAX_DISTANCE / max_exact)
    large = jnp.minimum(max_exact + (log_ratio * (N_BUCKETS - max_exact)).astype(jnp.int32), N_BUCKETS - 1)
    return jnp.where(d < max_exact, d, large)


def rel_bias_lookup(table, dist):
    return table[t5_bucket(dist)].astype(jnp.float32)


def layer_norm(x, g, b):
    xf = x.astype(jnp.float32)
    mu = jnp.mean(xf, axis=-1, keepdims=True)
    var = jnp.mean(jnp.square(xf - mu), axis=-1, keepdims=True)
    return ((xf - mu) * lax.rsqrt(var + LN_EPS) * g + b).astype(x.dtype)


def split_columns(u):
    offs = np.cumsum([w for _, w in IN_SPLITS])[:-1].tolist()
    return dict(zip([n for n, _ in IN_SPLITS], jnp.split(u, offs, axis=-1)))


def unblock(o):
    o = jnp.moveaxis(o, 0, 1)
    return o.reshape(o.shape[0], o.shape[1] * o.shape[2], *o.shape[3:])


def dilated_mixer(q, k, v, bias_tab):
    bsz, seq = q.shape[0], q.shape[1]
    n_blk = seq // Q_BLOCK
    outs, lses = [], []
    for g, (window, dil) in enumerate(A_GROUPS):
        hs = slice(g * A_HEADS_PER_GROUP, (g + 1) * A_HEADS_PER_GROUP)
        qg, kg, vg = q[:, :, hs], k[:, :, hs], v[:, :, hs]
        dist = jnp.arange(window // dil + 1) * dil
        bias = jnp.moveaxis(rel_bias_lookup(bias_tab[:, hs], dist), -1, 0)

        def block(i):
            t = i * Q_BLOCK + jnp.arange(Q_BLOCK)
            key_pos = t[:, None] - dist[None, :]
            idx = jnp.maximum(key_pos, 0)
            qb = lax.dynamic_slice_in_dim(qg, i * Q_BLOCK, Q_BLOCK, axis=1)
            kb, vb = kg[:, idx], vg[:, idx]
            s = jnp.einsum('bqhd,bqkhd->bhqk', qb, kb).astype(jnp.float32) * ATTN_SCALE + bias[None, :, None, :]
            s = jnp.where((key_pos >= 0)[None, None], s, NEG_INF)
            lse = jax.nn.logsumexp(s, axis=-1)
            p = jnp.exp(s - lse[..., None]).astype(vb.dtype)
            o = jnp.einsum('bhqk,bqkhd->bqhd', p, vb)
            return o, jnp.transpose(lse, (0, 2, 1))

        o_g, lse_g = lax.map(block, jnp.arange(n_blk))
        outs.append(unblock(o_g))
        lses.append(unblock(lse_g))
    w = jax.nn.softmax(jnp.stack(lses), axis=0)
    o = jnp.einsum('gbsh,gbshd->bshd', w.astype(v.dtype), jnp.stack(outs))
    return o.reshape(bsz, seq, A_OUT)


def nsa_mixer(q, k_cmp_src, v_cmp_src, k_slc, v_slc, k_win, v_win, gate_logits, b_gate,
              cmp_pe, cmp_w1, cmp_b1, cmp_w2, cmp_b2, bias_tab):
    bsz, seq = q.shape[0], q.shape[1]
    n_blk = seq // Q_BLOCK
    n_cmp = (seq - CMP_LEN) // CMP_STRIDE + 1
    n_slc = seq // SLC_LEN
    k_sel = min(N_SELECT, n_slc)
    pos = jnp.arange(seq)
    cidx = jnp.arange(n_cmp)[:, None] * CMP_STRIDE + jnp.arange(CMP_LEN)[None, :]
    kv = jnp.stack([k_cmp_src, v_cmp_src], axis=1)[:, :, cidx] + cmp_pe[None, :, None]
    kv = kv.reshape(bsz, 2, n_cmp, CMP_LEN * HEAD_DIM)
    hid = jax.nn.gelu(jnp.einsum('bcnf,cfe->bcne', kv, cmp_w1) + cmp_b1[None, :, None], approximate=False)
    kv_c = jnp.einsum('bcne,ced->bcnd', hid, cmp_w2) + cmp_b2[None, :, None]
    k_c, v_c = kv_c[:, 0], kv_c[:, 1]
    dist_c = pos[:, None] - (jnp.arange(n_cmp) * CMP_STRIDE + CMP_LEN - 1)[None, :]
    valid_c = (dist_c >= 0)[None, None]
    bias_c = jnp.moveaxis(rel_bias_lookup(bias_tab, dist_c), -1, 0)[None]
    s_c = jnp.einsum('bshd,bnd->bhsn', q, k_c).astype(jnp.float32) * ATTN_SCALE + bias_c
    p_c = jnp.where(valid_c, jax.nn.softmax(jnp.where(valid_c, s_c, NEG_INF), axis=-1), 0.0)
    o_cmp = jnp.einsum('bhsn,bnd->bshd', p_c.astype(v_c.dtype), v_c)
    ci = np.arange(n_cmp)[:, None]
    sj = np.arange(n_slc)[None, :]
    overlap = ((ci * CMP_STRIDE <= sj * SLC_LEN + SLC_LEN - 1)
               & (ci * CMP_STRIDE + CMP_LEN - 1 >= sj * SLC_LEN)).astype(np.float32)
    imp = jnp.einsum('bhsn,nj->bsj', p_c, jnp.asarray(overlap))
    blk = jnp.arange(n_slc)[None, :]
    cur = (pos // SLC_LEN)[:, None]
    forced = (blk == 0) | (blk == cur) | (blk == cur - 1)
    causal = blk * SLC_LEN <= pos[:, None]
    score = jnp.where(forced[None], FORCE_SCORE, jnp.where(causal[None], imp, NEG_INF))
    _, sel = lax.top_k(score, k_sel)
    k_blocks = k_slc.reshape(bsz, n_slc, SLC_LEN, HEAD_DIM)
    v_blocks = v_slc.reshape(bsz, n_slc, SLC_LEN, HEAD_DIM)
    kw_pad = jnp.pad(k_win, ((0, 0), (WIN, 0), (0, 0)))
    vw_pad = jnp.pad(v_win, ((0, 0), (WIN, 0), (0, 0)))
    q_off = jnp.arange(Q_BLOCK)
    dist_w = q_off[:, None] + WIN - jnp.arange(Q_BLOCK + WIN)[None, :]
    in_win = (dist_w >= 0) & (dist_w < WIN)
    bias_w = jnp.moveaxis(rel_bias_lookup(bias_tab, dist_w), -1, 0)[None]
    gather_blocks = jax.vmap(lambda blocks, ids: blocks[ids])

    def block(i):
        t0 = i * Q_BLOCK
        t = t0 + q_off
        qb = lax.dynamic_slice_in_dim(q, t0, Q_BLOCK, axis=1)
        sb = lax.dynamic_slice_in_dim(sel, t0, Q_BLOCK, axis=1)
        kb = gather_blocks(k_blocks, sb).reshape(bsz, Q_BLOCK, k_sel * SLC_LEN, HEAD_DIM)
        vb = gather_blocks(v_blocks, sb).reshape(bsz, Q_BLOCK, k_sel * SLC_LEN, HEAD_DIM)
        key_pos = (sb[..., None] * SLC_LEN + jnp.arange(SLC_LEN)).reshape(bsz, Q_BLOCK, k_sel * SLC_LEN)
        dist_s = t[None, :, None] - key_pos
        bias_s = jnp.moveaxis(rel_bias_lookup(bias_tab, dist_s), -1, 1)
        s_s = jnp.einsum('bqhd,bqnd->bhqn', qb, kb).astype(jnp.float32) * ATTN_SCALE + bias_s
        p_s = jax.nn.softmax(jnp.where((dist_s >= 0)[:, None], s_s, NEG_INF), axis=-1)
        o_s = jnp.einsum('bhqn,bqnd->bqhd', p_s.astype(vb.dtype), vb)
        kw = lax.dynamic_slice_in_dim(kw_pad, t0, Q_BLOCK + WIN, axis=1)
        vw = lax.dynamic_slice_in_dim(vw_pad, t0, Q_BLOCK + WIN, axis=1)
        valid_w = in_win & (t0 - WIN + jnp.arange(Q_BLOCK + WIN) >= 0)[None, :]
        s_w = jnp.einsum('bqhd,bnd->bhqn', qb, kw).astype(jnp.float32) * ATTN_SCALE + bias_w
        p_w = jax.nn.softmax(jnp.where(valid_w[None, None], s_w, NEG_INF), axis=-1)
        o_w = jnp.einsum('bhqn,bnd->bqhd', p_w.astype(vw.dtype), vw)
        return o_s, o_w

    o_slc, o_win = lax.map(block, jnp.arange(n_blk))
    o_slc, o_win = unblock(o_slc), unblock(o_win)
    g = jax.nn.sigmoid(gate_logits + b_gate).reshape(bsz, seq, 3, B_HEADS)[..., None]
    o = g[:, :, 0] * o_cmp + g[:, :, 1] * o_slc + g[:, :, 2] * o_win
    return o.reshape(bsz, seq, B_OUT)


def forgetting_mixer(q, k, v, f_logits, b_f):
    bsz, seq = q.shape[0], q.shape[1]
    n_blk = seq // Q_BLOCK
    log_f = jax.nn.log_sigmoid(f_logits.astype(jnp.float32) + b_f)
    c = jnp.moveaxis(jnp.cumsum(log_f, axis=1), -1, 1)
    key_pos = jnp.arange(seq)

    def block(i):
        t0 = i * Q_BLOCK
        t = t0 + jnp.arange(Q_BLOCK)
        qb = lax.dynamic_slice_in_dim(q, t0, Q_BLOCK, axis=1)
        c_q = lax.dynamic_slice_in_dim(c, t0, Q_BLOCK, axis=2)
        s = (jnp.einsum('bqhd,bshd->bhqs', qb, k).astype(jnp.float32) * ATTN_SCALE
             + c_q[..., None] - c[:, :, None, :])
        s = jnp.where((key_pos[None, :] <= t[:, None])[None, None], s, NEG_INF)
        p = jax.nn.softmax(s, axis=-1)
        return jnp.einsum('bhqs,bshd->bqhd', p.astype(v.dtype), v)

    o = unblock(lax.map(block, jnp.arange(n_blk)))
    return o.reshape(bsz, seq, C_OUT)


def conv_ffn(x, w_up, conv_w, conv_b, w_down):
    seq = x.shape[1]
    h = jnp.einsum('bsd,df->bsf', x, w_up)
    hp = jnp.pad(h, ((0, 0), (CONV_W - 1, 0), (0, 0)))
    h = conv_b + sum(conv_w[j] * hp[:, j:j + seq] for j in range(CONV_W))
    a, b = jnp.split(h, 2, axis=-1)
    return jnp.einsum('bsf,fd->bsd', jax.nn.gelu(a, approximate=False) * b, w_down)


def hybrid_layer(x, rel_bias, w_in, b_f, b_nsa_gate, cmp_pe, cmp_w1, cmp_b1, cmp_w2, cmp_b2,
                 w_gate, b_gate, w_pa, w_pb, w_pc, w_out, ln1_g, ln1_b,
                 w_up, conv_w, conv_b, w_down, ln2_g, ln2_b):
    bsz, seq, _ = x.shape
    u = split_columns(jnp.einsum('bsd,dn->bsn', x, w_in))

    def heads(t, h):
        return t.reshape(bsz, seq, h, HEAD_DIM)

    o_a = dilated_mixer(heads(u['a_q'], A_HEADS), heads(u['a_k'], A_HEADS), heads(u['a_v'], A_HEADS),
                        rel_bias[:, :A_HEADS])
    o_b = nsa_mixer(heads(u['b_q'], B_HEADS), u['b_k_cmp'], u['b_v_cmp'], u['b_k_slc'], u['b_v_slc'],
                    u['b_k_win'], u['b_v_win'], u['b_gate'], b_nsa_gate,
                    cmp_pe, cmp_w1, cmp_b1, cmp_w2, cmp_b2, rel_bias[:, A_HEADS:])
    o_c = forgetting_mixer(heads(u['c_q'], C_HEADS), heads(u['c_k'], C_HEADS), heads(u['c_v'], C_HEADS),
                           u['c_f'], b_f)
    g_a, g_b, g_c = jnp.split(jax.nn.sigmoid(jnp.einsum('bsd,de->bse', x, w_gate) + b_gate), 3, axis=-1)
    mixed = g_a * (o_a @ w_pa) + g_b * (o_b @ w_pb) + g_c * (o_c @ w_pc)
    x = layer_norm(ALPHA * x + mixed @ w_out, ln1_g, ln1_b)
    x = layer_norm(ALPHA * x + conv_ffn(x, w_up, conv_w, conv_b, w_down), ln2_g, ln2_b)
    return x


def setup_inputs(seed: int = 0) -> dict:
    key = jax.random.key(seed)
    ks = jax.random.split(key, 24)
    f32 = jnp.float32
    L, D, dh = DEPTH, D_MODEL, HEAD_DIM

    def nrm(k, shape, fan_in, gain=1.0):
        return jax.random.normal(k, shape, f32) * (gain * fan_in ** -0.5)

    def small(k, shape, s):
        return jax.random.normal(k, shape, f32) * s

    col_scale = np.concatenate([np.full(w, BETA if n in V_COLUMNS else 1.0, np.float32) for n, w in IN_SPLITS])
    return {
        'x': jax.random.normal(ks[0], (BATCH, SEQ, D), f32),
        'rel_bias': small(ks[1], (N_BUCKETS, BIAS_HEADS), 0.5),
        'w_in': nrm(ks[2], (L, D, N_IN), D) * jnp.asarray(col_scale),
        'b_f': jax.random.uniform(ks[3], (L, C_HEADS), f32, 1.0, 6.0),
        'b_nsa_gate': small(ks[4], (L, 3 * B_HEADS), 0.1),
        'cmp_pe': small(ks[5], (L, 2, CMP_LEN, dh), 0.1),
        'cmp_w1': nrm(ks[6], (L, 2, CMP_LEN * dh, dh), CMP_LEN * dh),
        'cmp_b1': small(ks[7], (L, 2, dh), 0.02),
        'cmp_w2': nrm(ks[8], (L, 2, dh, dh), dh),
        'cmp_b2': small(ks[9], (L, 2, dh), 0.02),
        'w_gate': nrm(ks[10], (L, D, 3 * D), D),
        'b_gate': small(ks[11], (L, 3 * D), 0.1),
        'w_pa': nrm(ks[12], (L, A_OUT, D), A_OUT, BETA),
        'w_pb': nrm(ks[13], (L, B_OUT, D), B_OUT, BETA),
        'w_pc': nrm(ks[14], (L, C_OUT, D), C_OUT, BETA),
        'w_out': nrm(ks[15], (L, D, D), D, BETA),
        'ln1_g': 1.0 + small(ks[16], (L, D), 0.05),
        'ln1_b': small(ks[17], (L, D), 0.02),
        'w_up': nrm(ks[18], (L, D, 2 * D_FF), D, BETA),
        'conv_w': nrm(ks[19], (L, CONV_W, 2 * D_FF), CONV_W),
        'conv_b': small(ks[20], (L, 2 * D_FF), 0.02),
        'w_down': nrm(ks[21], (L, D_FF, D), D_FF, BETA),
        'ln2_g': 1.0 + small(ks[22], (L, D), 0.05),
        'ln2_b': small(ks[23], (L, D), 0.02),
    }


def reference(x, rel_bias, w_in, b_f, b_nsa_gate, cmp_pe, cmp_w1, cmp_b1, cmp_w2, cmp_b2,
              w_gate, b_gate, w_pa, w_pb, w_pc, w_out, ln1_g, ln1_b,
              w_up, conv_w, conv_b, w_down, ln2_g, ln2_b):
    for l in range(DEPTH):
        x = hybrid_layer(x, rel_bias, w_in[l], b_f[l], b_nsa_gate[l], cmp_pe[l], cmp_w1[l], cmp_b1[l],
                         cmp_w2[l], cmp_b2[l], w_gate[l], b_gate[l], w_pa[l], w_pb[l], w_pc[l], w_out[l],
                         ln1_g[l], ln1_b[l], w_up[l], conv_w[l], conv_b[l], w_down[l], ln2_g[l], ln2_b[l])
    return x
```

```cpp
#include <hip/hip_runtime.h>
#include <hip/hip_cooperative_groups.h>
#include <cstdio>
#include <cstdint>
namespace cg = cooperative_groups;

#define LAS __attribute__((address_space(3)))
typedef unsigned short bf16_t;
typedef short bf16x8 __attribute__((ext_vector_type(8)));
typedef short s16x4 __attribute__((ext_vector_type(4)));
typedef float f32x2 __attribute__((ext_vector_type(2)));
typedef float f32x4 __attribute__((ext_vector_type(4)));
typedef float f32x16 __attribute__((ext_vector_type(16)));
typedef unsigned u32x2 __attribute__((ext_vector_type(2)));
typedef unsigned u32x4 __attribute__((ext_vector_type(4)));

constexpr int T_TOK = 16384, SEQ = 2048, DM = 2048, NBATCH = 8, NLAYER = 2;
constexpr int NIN = 5906, U_LD = 5888, G_LD = 6144, N1 = 12288, DFF = 5632;
constexpr int UC_AQ = 0, UC_AK = 768, UC_AV = 1536, UC_BQ = 2304, UC_CQ = 2816, UC_CK = 3584, UC_CV = 4352,
              UC_KSLC = 5120, UC_VSLC = 5248, UC_KWIN = 5376, UC_VWIN = 5504, UC_KCMP = 5632, UC_VCMP = 5760;
constexpr int KLD = 2048 + 64;
constexpr int OA_LD = 1536;
constexpr int FFA = 3072, FFB = 2560;
constexpr float ALPHA = 1.41421356237309515f;
constexpr float LN_EPS = 1e-5f;
constexpr float ATT_SCALE = 0.08838834764831845f;
constexpr float LOG2E = 1.4426950408889634f, LN2 = 0.6931471805599453f;

constexpr size_t AL(size_t x) { return (x + 255) & ~(size_t)255; }
constexpr size_t WS_W = 0;
constexpr size_t W1_BT1 = 0;
constexpr size_t W1_BTP = W1_BT1 + (size_t)N1 * KLD * 2;
constexpr size_t W1_BTOUT = W1_BTP + (size_t)2048 * 1536 * 2;
constexpr size_t W1_W1T = W1_BTOUT + (size_t)2048 * KLD * 2;
constexpr size_t W1_W2T = W1_W1T + (size_t)2 * 128 * 4096 * 2;
constexpr size_t W1_END = W1_W2T + (size_t)2 * 128 * 128 * 2;
constexpr size_t W2_BTUP = 0;
constexpr size_t W2_BTDN = W2_BTUP + (size_t)11264 * KLD * 2;
constexpr size_t W2_END = W2_BTDN + (size_t)2048 * 5632 * 2;
constexpr size_t WS_W_SIZE = AL(W1_END > W2_END ? W1_END : W2_END);
constexpr size_t WS_RA = WS_W + WS_W_SIZE;
constexpr size_t RA_U = 0, RA_G = (size_t)T_TOK * U_LD * 2;
constexpr size_t RA_SIZE = RA_G + (size_t)T_TOK * G_LD * 2;
constexpr size_t RA_H = 0, RA_ACT = (size_t)T_TOK * 6144 * 2;
static_assert(RA_ACT + (size_t)T_TOK * DFF * 2 <= RA_SIZE, "H+ACT must fit");
constexpr size_t WS_ZX = WS_RA + AL(RA_SIZE);
constexpr size_t ZX_SIZE = (size_t)T_TOK * DM * 4;
constexpr size_t ZX_OALL = 0, ZX_OAP = (size_t)T_TOK * OA_LD * 2, ZX_OBT = ZX_OAP + (size_t)3 * T_TOK * 256 * 4;
static_assert(ZX_OBT + (size_t)T_TOK * 512 * 4 <= ZX_SIZE, "attention temporaries must fit");
constexpr size_t WS_XB = WS_ZX + ZX_SIZE;
constexpr size_t WS_S = WS_XB + (size_t)T_TOK * KLD * 2;
constexpr size_t WS_CUM = WS_S + (size_t)T_TOK * 32 * 4;
constexpr size_t WS_LSE = WS_CUM + (size_t)NBATCH * 6 * SEQ * 4;
constexpr size_t WS_KC = WS_LSE + (size_t)3 * T_TOK * 2 * 4;
constexpr size_t WS_B1P = WS_KC + (size_t)2 * NBATCH * 128 * 128 * 2;
constexpr size_t WS_BLB = WS_B1P + 1024;
constexpr size_t WS_BLA = WS_BLB + 4 * 2052 * 4;
constexpr size_t WS_CTR = AL(WS_BLA + 6 * 132 * 4);
constexpr size_t WS_BAR = WS_CTR + 1024;
constexpr size_t WS_TOTAL = WS_BAR + 16384;

struct Params {
    const float* x; const float* rel_bias; const float* w_in; const float* b_f; const float* b_nsa_gate; const float* cmp_pe;
    const float* cmp_w1; const float* cmp_b1; const float* cmp_w2; const float* cmp_b2; const float* w_gate; const float* b_gate;
    const float* w_pa; const float* w_pb; const float* w_pc; const float* w_out; const float* ln1_g; const float* ln1_b;
    const float* w_up; const float* conv_w; const float* conv_b; const float* w_down; const float* ln2_g; const float* ln2_b;
    float* out; char* ws;
    int never; int pad;
};

__device__ __forceinline__ unsigned cvt_pk_bf16(float lo, float hi) { unsigned r; asm volatile("s_nop 1\n\tv_cvt_pk_bf16_f32 %0, %1, %2" : "=v"(r) : "v"(lo), "v"(hi)); return r; }
__device__ __forceinline__ bf16_t f2bf(float f) { return (bf16_t)(cvt_pk_bf16(f, 0.f) & 0xffffu); }
__device__ __forceinline__ float bf2f(bf16_t b) { return __uint_as_float(((unsigned)b) << 16); }
__device__ __forceinline__ float bflo(unsigned w) { return __uint_as_float(w << 16); }
__device__ __forceinline__ float bfhi(unsigned w) { return __uint_as_float(w & 0xffff0000u); }
__device__ __forceinline__ float sigmoidf_(float z) { return __builtin_amdgcn_rcpf(1.0f + __expf(-z)); }
__device__ __forceinline__ float gelu_erf(float v) { return 0.5f * v * (1.0f + erff(v * 0.70710678118654752f)); }
__device__ __forceinline__ float gelu_as(float v) {
    const float av = fabsf(v), t = __builtin_amdgcn_rcpf(av * 0.2316418882f + 1.0f);
    float q = t * 0.5307027145f + (-0.7265760135f); q = q * t + 0.7107068705f; q = q * t + (-0.142248368f); q = q * t + 0.127414796f; q = q * t;
    const float e = __builtin_amdgcn_exp2f((v * v) * (-0.72134752044f));
    const float m = v * (q * e);
    return v < 0.f ? m : v - m;
}
__device__ __forceinline__ int otid() { int t = threadIdx.x; asm volatile("" : "+v"(t)); return t; }
template <class T> __device__ __forceinline__ T* lp(T* q) { return q; }
__device__ __forceinline__ int li(int v) { return v; }
template <class T> __device__ __forceinline__ T* lv(T* q) { asm volatile("" : "+v"(q)); return q; }

#define XB_TMO      128
#define XB_XCNT(j)  (256  + 64 * (j))
#define XB_XSUB(j)  (1280 + 64 * (j))
#define XB_XGEN(j)  (2304 + 64 * (j))
#define XB_TOP      3328
#define XB_TOPGEN   3392
#define XCD_BAR_WORDS 3456
#define XB_SPIN_CAP (1u << 18)
__device__ __forceinline__ unsigned xb_ld(unsigned* p)              { return __hip_atomic_load(p, __ATOMIC_RELAXED, __HIP_MEMORY_SCOPE_AGENT); }
__device__ __forceinline__ unsigned xb_add(unsigned* p, unsigned v) { return __hip_atomic_fetch_add(p, v, __ATOMIC_RELAXED, __HIP_MEMORY_SCOPE_AGENT); }
__device__ __forceinline__ unsigned xb_xcc_id() { return (unsigned)__builtin_amdgcn_s_getreg((3 << 11) | 20) & 0xFu; }
#define XB_SPIN(cond, bar) do { unsigned _sp = 0; while (cond) { __builtin_amdgcn_s_sleep(1); \
    if ((++_sp & 255u) == 0u) { if (xb_ld(&(bar)[XB_TMO])) break; if (_sp > XB_SPIN_CAP) { atomicAdd(&(bar)[XB_TMO], 1u); break; } } } } while (0)
struct XcdBarrier { unsigned* bar; unsigned x; volatile LAS unsigned* st; };
__device__ __forceinline__ XcdBarrier xcd_barrier_post(unsigned* bar, volatile LAS unsigned* st) {
    XcdBarrier b; b.bar = bar; b.x = xb_xcc_id(); b.st = st;
    if (threadIdx.x == 0) (void)xb_add(&bar[XB_XCNT(b.x)], 1u);
    return b;
}
__device__ __forceinline__ void xcd_barrier_complete(unsigned* bar, unsigned x, unsigned& nloc, unsigned& nx) {
    const unsigned G = gridDim.x * gridDim.y * gridDim.z;
    unsigned sum, cnt, mine, sp = 0u;
    for (;;) {
        sum = 0u; cnt = 0u; mine = 0u;
#pragma unroll
        for (unsigned j = 0; j < 16; ++j) { const unsigned c = xb_ld(&bar[XB_XCNT(j)]); sum += c; cnt += (c > 0u) ? 1u : 0u; mine = (j == x) ? c : mine; }
        if (sum == G) break;
        __builtin_amdgcn_s_sleep(1);
        if ((++sp & 255u) == 0u) { if (xb_ld(&bar[XB_TMO])) break; if (sp > XB_SPIN_CAP) { atomicAdd(&bar[XB_TMO], 1u); break; } }
    }
    nloc = mine > 0u ? mine : 1u; nx = cnt > 0u ? cnt : 1u;
}
__device__ __forceinline__ void xcd_barrier(const XcdBarrier& b) {
    asm volatile("s_waitcnt vmcnt(0)" ::: "memory");
    __syncthreads();
    if (threadIdx.x == 0) {
        unsigned* bar = b.bar;
        __builtin_amdgcn_s_waitcnt(0);
        unsigned nloc = b.st[0], nx = b.st[1];
        if (nloc == 0u) { xcd_barrier_complete(bar, b.x, nloc, nx); b.st[0] = nloc; b.st[1] = nx; }
        const unsigned old = xb_add(&bar[XB_XSUB(b.x)], 1u);
        const unsigned gen = old / nloc;
        if (old + 1u == (gen + 1u) * nloc) {
            __builtin_amdgcn_fence(__ATOMIC_RELEASE, "agent");
            asm volatile("s_waitcnt vmcnt(0)" ::: "memory");
            const unsigned og = xb_add(&bar[XB_TOP], 1u);
            const unsigned tg = og / nx;
            if (og + 1u == (tg + 1u) * nx) xb_add(&bar[XB_TOPGEN], 1u);
            else XB_SPIN(xb_ld(&bar[XB_TOPGEN]) == tg, bar);
            __builtin_amdgcn_fence(__ATOMIC_ACQUIRE, "agent");
            xb_add(&bar[XB_XGEN(b.x)], 1u);
            asm volatile("s_waitcnt vmcnt(0)" ::: "memory");
        } else {
            XB_SPIN(xb_ld(&bar[XB_XGEN(b.x)]) == gen, bar);
            __builtin_amdgcn_fence(__ATOMIC_ACQUIRE, "agent");
            asm volatile("s_waitcnt vmcnt(0)" ::: "memory");
        }
    }
    __syncthreads();
}
namespace pg8 {
constexpr int BM = 256, BK = 64, HALF = 128, HTB = HALF * BK * 2, STAGE_BYTES = 8 * HTB, NXCD = 8, WGM = 4;
__host__ __device__ __forceinline__ int lds_byte(int r, int c) { const int st = (r >> 4) * 2 + (c >> 5), rr = r & 15, cc = c & 31, ob = rr * 64 + cc * 2; return st * 1024 + (ob ^ (((ob >> 9) & 1) << 5)); }
__host__ __device__ __forceinline__ void stage_rc(int b, int& R, int& C) { const int st = b / 1024, sb = b % 1024, swz = sb ^ (((sb >> 9) & 1) << 5); R = (st >> 1) * 16 + swz / 64; C = (st & 1) * 32 + (swz % 64) / 2; }
__host__ __device__ __forceinline__ int perm32(int rho) { const int n = rho >> 4, i = rho & 15; return 8 * (i >> 2) + 4 * n + (i & 3); }
struct Unit { int pm, pn, seg; };
struct Gemm { const bf16_t* A; const bf16_t* Bt; int M, N, K, lda, ldb; };
struct StaticOrder {
    int nM, nN, nwg, G, c;
    __device__ void init(int M, int N, int G_, int c_, int nseg_) { nM = M / BM; nN = N / BM; nwg = nM * nN; G = G_; c = c_; nseg = nseg_; }
    int nseg;
    __device__ bool next(int ii, Unit& u) const {
        const int i = nseg == 1 ? ii : ii / 3; u.seg = nseg == 1 ? 0 : ii - 3 * i;
        const long L = (long)i * G + c; if (L >= nwg) return false;
        int wgid = (int)L; { const int q = nwg / NXCD, r = nwg % NXCD, xcd = wgid % NXCD, off = wgid / NXCD; wgid = (xcd < r ? xcd * (q + 1) : r * (q + 1) + (xcd - r) * q) + off; }
        const int nig = WGM * nN, gid = wgid / nig, fm = gid * WGM, gsz = (nM - fm) < WGM ? (nM - fm) : WGM;
        u.pm = fm + ((wgid % nig) % gsz); u.pn = (wgid % nig) / gsz; return true;
    }
};
template <class Epi>
__device__ __forceinline__ void gemm_phase(LAS unsigned char* lds, const Gemm g, const StaticOrder& S, const Epi& E, unsigned* lockstep) {
    const int tid = otid(), wid = __builtin_amdgcn_readfirstlane(tid >> 6), lane = tid & 63, wr = wid >> 2, wc = wid & 3, fr = lane & 15, fq = lane >> 4;
    unsigned voffA[2], voffB[2];
#pragma unroll
    for (int i = 0; i < 2; ++i) { int R, C; stage_rc(tid * 16 + i * 8192, R, C); const int Rb = Epi::PERM ? ((R & ~31) + perm32(R & 31)) : R;
        voffA[i] = (unsigned)(R * g.lda + C) * 2u; voffB[i] = (unsigned)(Rb * g.ldb + C) * 2u; }
    const size_t kstep = (size_t)(BK * 2);
    const size_t hstepA = (size_t)HALF * g.lda * 2, hstepB = (size_t)HALF * g.ldb * 2;
    const size_t tstepA = 2 * hstepA, tstepB = 2 * hstepB;
    const unsigned ldsw = (unsigned)wid * 1024u;
    const int aoff = lds_byte(wr * 64 + fr, fq * 8), boff = lds_byte(wc * 32 + fr, fq * 8);
#define PG8_SA(b, h) (((b) * 2 + (h)) * HTB)
#define PG8_SB(b, h) ((4 + (b) * 2 + (h)) * HTB)
#define PG8_STAGE(bufoff, gbase, voff) do { _Pragma("unroll") for (int _i = 0; _i < 2; ++_i) \
        __builtin_amdgcn_global_load_lds((const unsigned*)((const char*)(gbase) + (voff)[_i]), (LAS unsigned*)(lds + (bufoff) + ldsw + _i * 8192), 16, 0, 0); } while (0)
#define PG8_LDA(dst, b, h) do { _Pragma("unroll") for (int m = 0; m < 4; ++m) _Pragma("unroll") for (int k = 0; k < 2; ++k) dst[m][k] = *(const LAS bf16x8*)(lds + PG8_SA(b, h) + aoff + m * 2048 + k * 1024); } while (0)
#define PG8_LDB(dst, b, h) do { _Pragma("unroll") for (int n = 0; n < 2; ++n) _Pragma("unroll") for (int k = 0; k < 2; ++k) dst[n][k] = *(const LAS bf16x8*)(lds + PG8_SB(b, h) + boff + n * 2048 + k * 1024); } while (0)
#define PG8_MMA(ai, bj, At, Bt) do { __builtin_amdgcn_s_setprio(1); _Pragma("unroll") for (int m = 0; m < 4; ++m) _Pragma("unroll") for (int n = 0; n < 2; ++n) _Pragma("unroll") for (int k = 0; k < 2; ++k) \
        acc[ai][bj][m][n] = __builtin_amdgcn_mfma_f32_16x16x32_bf16(Bt[n][k], At[m][k], acc[ai][bj][m][n], 0, 0, 0); __builtin_amdgcn_s_setprio(0); } while (0)
#define PG8_WAIT_V(n) asm volatile("s_waitcnt vmcnt(" #n ")" ::: "memory")
#define PG8_WAIT_L(n) asm volatile("s_waitcnt lgkmcnt(" #n ")" ::: "memory")
#define PG8_BAR __builtin_amdgcn_s_barrier()
#define PG8_SCHED __builtin_amdgcn_sched_barrier(0)
    Unit cur, nxt; int ui = 0;
    if (!S.next(0, cur)) return;
    f32x4 acc[2][2][4][2];
#pragma unroll
    for (int a = 0; a < 2; ++a)
#pragma unroll
        for (int b = 0; b < 2; ++b)
#pragma unroll
            for (int m = 0; m < 4; ++m)
#pragma unroll
                for (int n = 0; n < 2; ++n) acc[a][b][m][n] = (f32x4){0.f, 0.f, 0.f, 0.f};
    bf16x8 At[4][2], B0[2][2], B1[2][2];
#define PG8_KOFF(u) (Epi::NSEG == 1 ? 0 : ((u).seg == 0 ? 0 : ((u).seg == 1 ? 256 : 768)))
#define PG8_NT(u) (Epi::NSEG == 1 ? g.K / BK : ((u).seg == 0 ? 4 : ((u).seg == 1 ? 8 : 12)))
    const char* cA = (const char*)g.A + (size_t)(Epi::AFIX ? (cur.pm & 7) : cur.pm) * tstepA + PG8_KOFF(cur) * 2; const char* cB = (const char*)g.Bt + (size_t)(Epi::BFIX ? (cur.pn & 3) : cur.pn) * tstepB + PG8_KOFF(cur) * 2;
    int nt = PG8_NT(cur);
    PG8_STAGE(PG8_SB(0, 0), cB, voffB); PG8_STAGE(PG8_SA(0, 0), cA, voffA); PG8_STAGE(PG8_SB(0, 1), cB + hstepB, voffB); PG8_STAGE(PG8_SA(0, 1), cA + hstepA, voffA);
    if (wr == 1) PG8_BAR;
    PG8_WAIT_V(4); PG8_BAR;
    PG8_STAGE(PG8_SB(1, 0), cB + kstep, voffB); PG8_STAGE(PG8_SA(1, 0), cA + kstep, voffA); PG8_STAGE(PG8_SB(1, 1), cB + hstepB + kstep, voffB);
    PG8_WAIT_V(6); PG8_BAR;
    for (;;) {
        const bool has_next = S.next(ui + 1, nxt);
        const char* nA = has_next ? (const char*)g.A + (size_t)(Epi::AFIX ? (nxt.pm & 7) : nxt.pm) * tstepA + PG8_KOFF(nxt) * 2 : cA; const char* nB = has_next ? (const char*)g.Bt + (size_t)(Epi::BFIX ? (nxt.pn & 3) : nxt.pn) * tstepB + PG8_KOFF(nxt) * 2 : cB;
        for (int t = 0; t < nt; t += 2) {
            const bool last = (t == nt - 2);
            const char* a1 = cA + (size_t)(t + 1) * kstep;
            const char* a2 = last ? nA : cA + (size_t)(t + 2) * kstep; const char* b2 = last ? nB : cB + (size_t)(t + 2) * kstep;
            const char* a3 = a2 + kstep; const char* b3 = b2 + kstep;
            PG8_LDB(B0, 0, 0); PG8_SCHED; PG8_LDA(At, 0, 0); PG8_STAGE(PG8_SA(1, 1), a1 + hstepA, voffA);
            PG8_WAIT_L(8); PG8_BAR; PG8_WAIT_L(0); PG8_MMA(0, 0, At, B0); PG8_BAR; PG8_SCHED;
            PG8_LDB(B1, 0, 1); PG8_STAGE(PG8_SB(0, 0), b2, voffB);
            PG8_BAR; PG8_WAIT_L(0); PG8_MMA(0, 1, At, B1); PG8_BAR;
            PG8_LDA(At, 0, 1); PG8_STAGE(PG8_SA(0, 0), a2, voffA);
            PG8_BAR; PG8_WAIT_L(0); PG8_MMA(1, 0, At, B0); PG8_BAR; PG8_SCHED;
            PG8_STAGE(PG8_SB(0, 1), b2 + hstepB, voffB);
            PG8_WAIT_V(6); PG8_BAR; PG8_MMA(1, 1, At, B1); PG8_BAR;
            PG8_LDB(B0, 1, 0); PG8_SCHED; PG8_LDA(At, 1, 0); PG8_STAGE(PG8_SA(0, 1), a2 + hstepA, voffA);
            PG8_WAIT_L(8); PG8_BAR; PG8_WAIT_L(0); PG8_MMA(0, 0, At, B0); PG8_BAR; PG8_SCHED;
            PG8_LDB(B1, 1, 1); PG8_STAGE(PG8_SB(1, 0), b3, voffB);
            PG8_BAR; PG8_WAIT_L(0); PG8_MMA(0, 1, At, B1); PG8_BAR;
            PG8_LDA(At, 1, 1); PG8_STAGE(PG8_SA(1, 0), a3, voffA);
            PG8_BAR; PG8_WAIT_L(0); PG8_MMA(1, 0, At, B0); PG8_BAR; PG8_SCHED;
            PG8_STAGE(PG8_SB(1, 1), b3 + hstepB, voffB);
            PG8_WAIT_V(6); PG8_BAR; PG8_MMA(1, 1, At, B1); PG8_BAR;
        }
        E(acc, cur, wr, wc, fr, fq);
        if (!has_next) break;
        if (lockstep) {
            if (tid == 0) { __hip_atomic_fetch_add(lockstep, 1u, __ATOMIC_RELAXED, __HIP_MEMORY_SCOPE_AGENT);
                const unsigned want = (unsigned)(ui + 1) * gridDim.x; unsigned sp = 0;
                while (__hip_atomic_load(lockstep, __ATOMIC_RELAXED, __HIP_MEMORY_SCOPE_AGENT) < want && ++sp < (1u << 16)) __builtin_amdgcn_s_sleep(1); }
            PG8_BAR;
        }
#pragma unroll
        for (int a = 0; a < 2; ++a)
#pragma unroll
            for (int b = 0; b < 2; ++b)
#pragma unroll
                for (int m = 0; m < 4; ++m)
#pragma unroll
                    for (int n = 0; n < 2; ++n) acc[a][b][m][n] = (f32x4){0.f, 0.f, 0.f, 0.f};
        cur = nxt; cA = nA; cB = nB; ++ui; nt = PG8_NT(cur);
    }
    PG8_WAIT_V(0);
    if (wr == 0) PG8_BAR;
    PG8_BAR;
#undef PG8_SA
#undef PG8_KOFF
#undef PG8_NT
#undef PG8_SB
#undef PG8_STAGE
#undef PG8_LDA
#undef PG8_LDB
#undef PG8_MMA
#undef PG8_WAIT_V
#undef PG8_WAIT_L
#undef PG8_BAR
#undef PG8_SCHED
}

struct Epi1 {
    static constexpr bool PERM = true, AFIX = false, BFIX = false; static constexpr int NSEG = 1;
    bf16_t* U; bf16_t* G; float* S; const float* b_gate;
    __device__ __forceinline__ void operator()(const f32x4 (&acc)[2][2][4][2], const Unit& u, int wr, int wc, int fr, int fq) const {
        const int row0 = u.pm * BM + wr * 64 + fr;
        if (u.pn < 23) {
            const int col0 = u.pn * BM + wc * 32 + 8 * fq;
#pragma unroll
            for (int ai = 0; ai < 2; ++ai)
#pragma unroll
                for (int m = 0; m < 4; ++m) { bf16_t* rowp = U + (size_t)(row0 + ai * HALF + m * 16) * U_LD + col0;
#pragma unroll
                    for (int bj = 0; bj < 2; ++bj) { const f32x4 v0 = acc[ai][bj][m][0], v1 = acc[ai][bj][m][1];
                        u32x4 w; w.x = cvt_pk_bf16(v0[0], v0[1]); w.y = cvt_pk_bf16(v0[2], v0[3]); w.z = cvt_pk_bf16(v1[0], v1[1]); w.w = cvt_pk_bf16(v1[2], v1[3]);
                        *(u32x4*)(rowp + bj * HALF) = w; } }
        } else if (u.pn < 47) {
            const int col0 = (u.pn - 23) * BM + wc * 32 + 8 * fq;
            f32x4 bv[2][2];
#pragma unroll
            for (int bj = 0; bj < 2; ++bj)
#pragma unroll
                for (int n = 0; n < 2; ++n) bv[bj][n] = *(const f32x4*)(b_gate + col0 + bj * HALF + 4 * n);
#pragma unroll
            for (int ai = 0; ai < 2; ++ai)
#pragma unroll
                for (int m = 0; m < 4; ++m) { bf16_t* rowp = G + (size_t)(row0 + ai * HALF + m * 16) * G_LD + col0;
#pragma unroll
                    for (int bj = 0; bj < 2; ++bj) { f32x4 v0 = acc[ai][bj][m][0] + bv[bj][0], v1 = acc[ai][bj][m][1] + bv[bj][1];
#pragma unroll
                        for (int j = 0; j < 4; ++j) { v0[j] = sigmoidf_(v0[j]); v1[j] = sigmoidf_(v1[j]); }
                        u32x4 w; w.x = cvt_pk_bf16(v0[0], v0[1]); w.y = cvt_pk_bf16(v0[2], v0[3]); w.z = cvt_pk_bf16(v1[0], v1[1]); w.w = cvt_pk_bf16(v1[2], v1[3]);
                        *(u32x4*)(rowp + bj * HALF) = w; } }
        } else {
            if (wc == 0) {
#pragma unroll
                for (int ai = 0; ai < 2; ++ai)
#pragma unroll
                    for (int m = 0; m < 4; ++m) { float* rowp = S + (size_t)(row0 + ai * HALF + m * 16) * 32 + 8 * fq;
                        *(f32x4*)(rowp) = acc[ai][0][m][0]; *(f32x4*)(rowp + 4) = acc[ai][0][m][1]; }
            }
        }
    }
};
struct Epi2 {
    static constexpr bool PERM = true, AFIX = false, BFIX = false; static constexpr int NSEG = 3;
    const bf16_t* G; bf16_t* O; bf16_t* T;
    __device__ __forceinline__ void operator()(const f32x4 (&acc)[2][2][4][2], const Unit& u, int wr, int wc, int fr, int fq) const {
        const int row0 = u.pm * BM + wr * 64 + fr, col0 = u.pn * BM + wc * 32 + 8 * fq, seg = u.seg;
        u32x4 ga[2], ta[2];
        { const size_t row = (size_t)row0;
          ga[0] = *(const u32x4*)(G + row * G_LD + seg * 2048 + col0); ga[1] = *(const u32x4*)(G + row * G_LD + seg * 2048 + col0 + HALF);
          if (seg > 0) { ta[0] = *(const u32x4*)(T + row * DM + col0); ta[1] = *(const u32x4*)(T + row * DM + col0 + HALF); } else { ta[0] = (u32x4){0u, 0u, 0u, 0u}; ta[1] = ta[0]; } }
#pragma unroll
        for (int g = 0; g < 8; ++g) { const int ai = g >> 2, m = g & 3; const size_t row = (size_t)(row0 + ai * HALF + m * 16);
            u32x4 gn[2] = {ga[0], ga[1]}, tn[2] = {ta[0], ta[1]};
            if (g < 7) { const size_t rown = (size_t)(row0 + ((g + 1) >> 2) * HALF + ((g + 1) & 3) * 16);
                gn[0] = *(const u32x4*)(G + rown * G_LD + seg * 2048 + col0); gn[1] = *(const u32x4*)(G + rown * G_LD + seg * 2048 + col0 + HALF);
                if (seg > 0) { tn[0] = *(const u32x4*)(T + rown * DM + col0); tn[1] = *(const u32x4*)(T + rown * DM + col0 + HALF); } }
            bf16_t* tp = (seg < 2 ? T + row * DM : O + row * KLD) + col0;
#pragma unroll
            for (int bj = 0; bj < 2; ++bj) {
                const u32x4 a = ga[bj];
                const f32x4 g0 = {bflo(a.x), bfhi(a.x), bflo(a.y), bfhi(a.y)}, g1 = {bflo(a.z), bfhi(a.z), bflo(a.w), bfhi(a.w)};
                f32x4 v0 = acc[ai][bj][m][0] * g0, v1 = acc[ai][bj][m][1] * g1;
                if (seg > 0) { const u32x4 t = ta[bj];
                    v0 += (f32x4){bflo(t.x), bfhi(t.x), bflo(t.y), bfhi(t.y)}; v1 += (f32x4){bflo(t.z), bfhi(t.z), bflo(t.w), bfhi(t.w)}; }
                u32x4 w; w.x = cvt_pk_bf16(v0[0], v0[1]); w.y = cvt_pk_bf16(v0[2], v0[3]); w.z = cvt_pk_bf16(v1[0], v1[1]); w.w = cvt_pk_bf16(v1[2], v1[3]);
                *(u32x4*)(tp + bj * HALF) = w; }
            ga[0] = gn[0]; ga[1] = gn[1]; ta[0] = tn[0]; ta[1] = tn[1];
            asm volatile("" ::: "memory"); }
    }
};
struct EpiRes {
    static constexpr bool PERM = false, AFIX = false, BFIX = false; static constexpr int NSEG = 1;
    const float* R; float* Z;
    __device__ __forceinline__ void operator()(const f32x4 (&acc)[2][2][4][2], const Unit& u, int wr, int wc, int fr, int fq) const {
        const int row0 = u.pm * BM + wr * 64 + fr, col0 = u.pn * BM + wc * 32 + 4 * fq;
#pragma unroll
        for (int ai = 0; ai < 2; ++ai) {
            f32x4 r[4][2][2];
#pragma unroll
            for (int m = 0; m < 4; ++m) { const size_t off = (size_t)(row0 + ai * HALF + m * 16) * DM + col0;
#pragma unroll
                for (int bj = 0; bj < 2; ++bj)
#pragma unroll
                    for (int n = 0; n < 2; ++n) r[m][bj][n] = *(const f32x4*)(R + off + bj * HALF + n * 16); }
            asm volatile("" ::: "memory");
#pragma unroll
            for (int m = 0; m < 4; ++m) { const size_t off = (size_t)(row0 + ai * HALF + m * 16) * DM + col0;
#pragma unroll
                for (int bj = 0; bj < 2; ++bj)
#pragma unroll
                    for (int n = 0; n < 2; ++n) *(f32x4*)(Z + off + bj * HALF + n * 16) = r[m][bj][n] * ALPHA + acc[ai][bj][m][n]; }
            asm volatile("" ::: "memory");
        }
    }
};
struct EpiH {
    static constexpr bool PERM = true, AFIX = false, BFIX = false; static constexpr int NSEG = 1;
    bf16_t* H; int ldh;
    __device__ __forceinline__ void operator()(const f32x4 (&acc)[2][2][4][2], const Unit& u, int wr, int wc, int fr, int fq) const {
        const int row0 = u.pm * BM + wr * 64 + fr, col0 = u.pn * BM + wc * 32 + 8 * fq;
#pragma unroll
        for (int ai = 0; ai < 2; ++ai)
#pragma unroll
            for (int m = 0; m < 4; ++m) { bf16_t* rowp = H + (size_t)(row0 + ai * HALF + m * 16) * ldh + col0;
#pragma unroll
                for (int bj = 0; bj < 2; ++bj) { const f32x4 v0 = acc[ai][bj][m][0], v1 = acc[ai][bj][m][1];
                    u32x4 w; w.x = cvt_pk_bf16(v0[0], v0[1]); w.y = cvt_pk_bf16(v0[2], v0[3]); w.z = cvt_pk_bf16(v1[0], v1[1]); w.w = cvt_pk_bf16(v1[2], v1[3]);
                    *(u32x4*)(rowp + bj * HALF) = w; } }
    }
};
}
struct Seg { const float* src; bf16_t* dst; int ld_src, K, col0, width, ld_dst, row0, rows, tile0; };
__device__ __forceinline__ void add_seg(Seg* segs, int& n, int& tiles, const float* src, bf16_t* dst, int ld_src, int K, int col0, int width, int ld_dst, int row0, int rows) {
    Seg s; s.src = src; s.dst = dst; s.ld_src = ld_src; s.K = K; s.col0 = col0; s.width = width; s.ld_dst = ld_dst; s.row0 = row0; s.rows = rows; s.tile0 = tiles;
    segs[n] = s; ++n; tiles += ((rows + 127) / 128) * (K / 128);
    asm volatile("" ::: "memory");
}
__device__ __forceinline__ void convert_tiles(const Params& p, int layer, int group, LAS unsigned char* lds, int t_begin, int t_end, int t_step) {
    char* const wsl = lp(p.ws);
    Seg* segs = (Seg*)(unsigned char*)lds; LAS int* meta = (LAS int*)(lds + 3072); LAS float* tile = (LAS float*)(lds + 4096);
    char* W = wsl + WS_W;
    __syncthreads();
    if (threadIdx.x == 0) {
        int n = 0, tiles = 0;
        if (group == 1) {
            const float* win = p.w_in + (size_t)layer * 2048 * NIN; bf16_t* bt1 = (bf16_t*)(W + W1_BT1);
            add_seg(segs, n, tiles, win, bt1, NIN, 2048, 0, 2816, KLD, 0, 2816);
            add_seg(segs, n, tiles, win, bt1, NIN, 2048, 3596, 2304, KLD, 2816, 2304);
            add_seg(segs, n, tiles, win, bt1, NIN, 2048, 3072, 512, KLD, 5120, 512);
            add_seg(segs, n, tiles, win, bt1, NIN, 2048, 2816, 256, KLD, 5632, 256);
            add_seg(segs, n, tiles, p.w_gate + (size_t)layer * 2048 * 6144, bt1, 6144, 2048, 0, 6144, KLD, 5888, 6144);
            add_seg(segs, n, tiles, win, bt1, NIN, 2048, 3584, 12, KLD, 12032, 12);
            add_seg(segs, n, tiles, win, bt1, NIN, 2048, 5900, 6, KLD, 12044, 6);
            add_seg(segs, n, tiles, win, bt1, NIN, 2048, 0, 0, KLD, 12050, 238);
            bf16_t* btp = (bf16_t*)(W + W1_BTP);
            add_seg(segs, n, tiles, p.w_pa + (size_t)layer * 256 * 2048, btp, 2048, 256, 0, 2048, 1536, 0, 2048);
            add_seg(segs, n, tiles, p.w_pb + (size_t)layer * 512 * 2048, btp + 256, 2048, 512, 0, 2048, 1536, 0, 2048);
            add_seg(segs, n, tiles, p.w_pc + (size_t)layer * 768 * 2048, btp + 768, 2048, 768, 0, 2048, 1536, 0, 2048);
            add_seg(segs, n, tiles, p.w_out + (size_t)layer * 2048 * 2048, (bf16_t*)(W + W1_BTOUT), 2048, 2048, 0, 2048, KLD, 0, 2048);
            for (int c = 0; c < 2; ++c) {
                add_seg(segs, n, tiles, p.cmp_w1 + ((size_t)layer * 2 + c) * 4096 * 128, (bf16_t*)(W + W1_W1T) + (size_t)c * 128 * 4096, 128, 4096, 0, 128, 4096, 0, 128);
                add_seg(segs, n, tiles, p.cmp_w2 + ((size_t)layer * 2 + c) * 128 * 128, (bf16_t*)(W + W1_W2T) + (size_t)c * 128 * 128, 128, 128, 0, 128, 128, 0, 128);
            }
        } else {
            const float* wup = p.w_up + (size_t)layer * 2048 * 11264; bf16_t* btu = (bf16_t*)(W + W2_BTUP);
            add_seg(segs, n, tiles, wup, btu, 11264, 2048, 0, FFA, KLD, 0, FFA);
            add_seg(segs, n, tiles, wup, btu, 11264, 2048, DFF, FFA, KLD, FFA, FFA);
            add_seg(segs, n, tiles, wup, btu, 11264, 2048, FFA, FFB, KLD, 2 * FFA, FFB);
            add_seg(segs, n, tiles, wup, btu, 11264, 2048, DFF + FFA, FFB, KLD, 2 * FFA + FFB, FFB);
            add_seg(segs, n, tiles, p.w_down + (size_t)layer * DFF * 2048, (bf16_t*)(W + W2_BTDN), 2048, DFF, 0, 2048, DFF, 0, 2048);
        }
        meta[0] = n; meta[1] = tiles;
    }
    __syncthreads();
    const int nseg = meta[0], total = meta[1];
    const int tid = otid();
    float r[32]; Seg sg; int n0 = 0, k0 = 0;
    auto locate = [&](int t) { int s = 0; while (s + 1 < nseg && segs[s + 1].tile0 <= t) ++s; sg = segs[s];
        const int local = t - sg.tile0, nk = sg.K / 128, rt = local / nk, kt = local - rt * nk; n0 = rt * 128; k0 = kt * 128; };
    auto issue = [&]() { const int n = tid & 127, kk0 = tid >> 7; const bool ok = (n0 + n) < sg.width;
        const float* sp = sg.src + (size_t)(k0 + kk0) * sg.ld_src + sg.col0 + n0 + n;
#pragma unroll
        for (int i = 0; i < 32; ++i) r[i] = ok ? sp[(size_t)(4 * i) * sg.ld_src] : 0.f; };
    const int tend = t_end < total ? t_end : total;
    int t = t_begin;
    if (t < tend) { locate(t); issue(); }
    while (t < tend) {
        { const int n = tid & 127, kk0 = tid >> 7;
#pragma unroll
          for (int i = 0; i < 32; ++i) tile[(kk0 + 4 * i) * 129 + n] = r[i]; }
        __syncthreads();
        const Seg cs = sg; const int cn0 = n0, ck0 = k0;
        const int tn = t + t_step;
        if (tn < tend) { locate(tn); issue(); }
        { const int kp = (tid & 63) * 2, nn0 = tid >> 6;
#pragma unroll
          for (int j = 0; j < 16; ++j) { const int n = nn0 + 8 * j;
              if (cn0 + n < cs.rows) *(unsigned*)(cs.dst + (size_t)(cs.row0 + cn0 + n) * cs.ld_dst + ck0 + kp) = cvt_pk_bf16(tile[kp * 129 + n], tile[(kp + 1) * 129 + n]); } }
        __syncthreads();
        t = tn;
    }
}
__device__ __forceinline__ void convert_phase(const Params& p, int layer, int group, LAS unsigned char* lds) { convert_tiles(p, layer, group, lds, blockIdx.x, 1 << 30, gridDim.x); }
constexpr int CV2_TILES = (11264 / 128) * (2048 / 128) + (2048 / 128) * (DFF / 128), CV2_CHUNK = 32, CV2_ITEMS = (CV2_TILES + CV2_CHUNK - 1) / CV2_CHUNK;
__device__ __forceinline__ void b1p_phase(const Params& p, int layer) {
    char* const wsl = lp(p.ws);
    const int tid_ = otid(), lane = tid_ & 63, wid = tid_ >> 6;
    float* b1p = (float*)(wsl + WS_B1P);
    for (int o = blockIdx.x + gridDim.x * wid; o < 256; o += gridDim.x * 8) { const int c = o >> 7, e = o & 127;
        const float* pe = p.cmp_pe + ((size_t)layer * 2 + c) * 4096 + lane; const float* w1 = p.cmp_w1 + ((size_t)layer * 2 + c) * 4096 * 128 + (size_t)lane * 128 + e;
        float s = 0.f;
#pragma unroll 16
        for (int i = 0; i < 64; ++i) s += pe[i * 64] * w1[(size_t)i * 64 * 128];
#pragma unroll
        for (int off = 32; off >= 1; off >>= 1) s += __shfl_xor(s, off);
        if (lane == 0) b1p[o] = s + p.cmp_b1[(layer * 2 + c) * 128 + e]; }
}
__device__ __forceinline__ int t5_bucket_dev(int d) {
    if (d < 16) return d;
    const float lr = logf((float)d / 16.0f) / 4.852030263919617f; const int lg = 16 + (int)(lr * 16.0f); return lg < 31 ? lg : 31;
}
__device__ __forceinline__ void bucket_phase(const Params& p) {
    char* const wsl = lp(p.ws);
    float* blb = (float*)(wsl + WS_BLB); float* bla = (float*)(wsl + WS_BLA);
    for (int i = blockIdx.x * 512 + threadIdx.x; i < 4 * 2052 + 6 * 132; i += gridDim.x * 512) {
        if (i < 4 * 2052) { const int h = i / 2052, d = i - h * 2052; blb[i] = (d <= 2048) ? p.rel_bias[t5_bucket_dev(d) * 10 + 6 + h] * LOG2E : 0.f; }
        else { const int k = i - 4 * 2052, head = k / 132, j = k - head * 132, dil = head < 2 ? 1 : (head < 4 ? 4 : 16);
            bla[k] = (j <= 128) ? p.rel_bias[t5_bucket_dev(j * dil) * 10 + head] * LOG2E : 0.f; }
    }
}
__device__ __forceinline__ void xcvt_phase(const float* x, bf16_t* xb) {
    const size_t n8 = (size_t)T_TOK * DM / 8;
#pragma unroll 4
    for (size_t i = (size_t)blockIdx.x * 512 + threadIdx.x; i < n8; i += (size_t)gridDim.x * 512) {
        const f32x4 a = *(const f32x4*)(x + i * 8), b = *(const f32x4*)(x + i * 8 + 4);
        u32x4 w; w.x = cvt_pk_bf16(a[0], a[1]); w.y = cvt_pk_bf16(a[2], a[3]); w.z = cvt_pk_bf16(b[0], b[1]); w.w = cvt_pk_bf16(b[2], b[3]);
        const size_t row = i >> 8, c8 = i & 255;
        *(u32x4*)(xb + row * KLD + c8 * 8) = w; }
}
template <bool WB>
__device__ __forceinline__ void ln_phase(const float* src, float* dstf, bf16_t* dstb, const float* gam, const float* bet) {
    const int tid_ = otid(), lane = tid_ & 63, gw = blockIdx.x * 8 + (tid_ >> 6), nw = gridDim.x * 8;
    for (int row = gw; row < T_TOK; row += nw) {
        const float* sp = src + (size_t)row * DM; f32x4 v[8]; float s = 0.f;
#pragma unroll
        for (int i = 0; i < 8; ++i) { v[i] = *(const f32x4*)(sp + (i * 64 + lane) * 4); s += (v[i][0] + v[i][1]) + (v[i][2] + v[i][3]); }
#pragma unroll
        for (int off = 32; off >= 1; off >>= 1) s += __shfl_xor(s, off);
        const float mu = s * (1.0f / 2048.0f); float q = 0.f;
#pragma unroll
        for (int i = 0; i < 8; ++i) { const f32x4 d = v[i] - mu; q += (d[0] * d[0] + d[1] * d[1]) + (d[2] * d[2] + d[3] * d[3]); }
#pragma unroll
        for (int off = 32; off >= 1; off >>= 1) q += __shfl_xor(q, off);
        const float rstd = rsqrtf(q * (1.0f / 2048.0f) + LN_EPS);
#pragma unroll
        for (int i = 0; i < 8; ++i) { const int c = (i * 64 + lane) * 4; const f32x4 g = *(const f32x4*)(gam + c), b = *(const f32x4*)(bet + c);
            const f32x4 y = (v[i] - mu) * rstd * g + b;
            *(f32x4*)(dstf + (size_t)row * DM + c) = y;
            if (WB) { u32x2 w; w.x = cvt_pk_bf16(y[0], y[1]); w.y = cvt_pk_bf16(y[2], y[3]); *(u32x2*)(dstb + (size_t)row * KLD + c) = w; } }
    }
}
__device__ __forceinline__ void conv_phase(const bf16_t* H, int FF, int foff, const float* conv_w, const float* conv_b, bf16_t* ACT) {
    const int nch = FF / 8, ntask = (T_TOK / 16) * nch, ldh = 2 * FF;
    for (int task = blockIdx.x * 512 + otid(); task < ntask; task += gridDim.x * 512) {
        const int tg = task / nch, ch = task - tg * nch, t0 = tg * 16, c0 = ch * 8;
        float wa[3][8], wb[3][8], ba[8], bb[8];
#pragma unroll
        for (int j = 0; j < 3; ++j)
#pragma unroll
            for (int e = 0; e < 8; ++e) { wa[j][e] = conv_w[(size_t)j * 2 * DFF + foff + c0 + e]; wb[j][e] = conv_w[(size_t)j * 2 * DFF + DFF + foff + c0 + e]; }
#pragma unroll
        for (int e = 0; e < 8; ++e) { ba[e] = conv_b[foff + c0 + e]; bb[e] = conv_b[DFF + foff + c0 + e]; }
        float a1[8], a2[8], b1[8], b2[8];
        const bool first = (t0 % SEQ) == 0;
        { u32x4 za = {0, 0, 0, 0}, zb = za, ya = za, yb = za;
          if (!first) { za = *(const u32x4*)(H + (size_t)(t0 - 1) * ldh + c0); zb = *(const u32x4*)(H + (size_t)(t0 - 1) * ldh + FF + c0);
                        ya = *(const u32x4*)(H + (size_t)(t0 - 2) * ldh + c0); yb = *(const u32x4*)(H + (size_t)(t0 - 2) * ldh + FF + c0); }
          a1[0] = bflo(za.x); a1[1] = bfhi(za.x); a1[2] = bflo(za.y); a1[3] = bfhi(za.y); a1[4] = bflo(za.z); a1[5] = bfhi(za.z); a1[6] = bflo(za.w); a1[7] = bfhi(za.w);
          b1[0] = bflo(zb.x); b1[1] = bfhi(zb.x); b1[2] = bflo(zb.y); b1[3] = bfhi(zb.y); b1[4] = bflo(zb.z); b1[5] = bfhi(zb.z); b1[6] = bflo(zb.w); b1[7] = bfhi(zb.w);
          a2[0] = bflo(ya.x); a2[1] = bfhi(ya.x); a2[2] = bflo(ya.y); a2[3] = bfhi(ya.y); a2[4] = bflo(ya.z); a2[5] = bfhi(ya.z); a2[6] = bflo(ya.w); a2[7] = bfhi(ya.w);
          b2[0] = bflo(yb.x); b2[1] = bfhi(yb.x); b2[2] = bflo(yb.y); b2[3] = bfhi(yb.y); b2[4] = bflo(yb.z); b2[5] = bfhi(yb.z); b2[6] = bflo(yb.w); b2[7] = bfhi(yb.w); }
#pragma unroll 1
        for (int i0 = 0; i0 < 16; i0 += 8) {
            u32x4 xa4[8], xb4[8];
#pragma unroll
            for (int j = 0; j < 8; ++j) { xa4[j] = *(const u32x4*)(H + (size_t)(t0 + i0 + j) * ldh + c0); xb4[j] = *(const u32x4*)(H + (size_t)(t0 + i0 + j) * ldh + FF + c0); }
            asm volatile("" ::: "memory");
#pragma unroll
            for (int j = 0; j < 8; ++j) { const u32x4 xa = xa4[j], xb = xb4[j];
                float a0[8], b0[8];
                a0[0] = bflo(xa.x); a0[1] = bfhi(xa.x); a0[2] = bflo(xa.y); a0[3] = bfhi(xa.y); a0[4] = bflo(xa.z); a0[5] = bfhi(xa.z); a0[6] = bflo(xa.w); a0[7] = bfhi(xa.w);
                b0[0] = bflo(xb.x); b0[1] = bfhi(xb.x); b0[2] = bflo(xb.y); b0[3] = bfhi(xb.y); b0[4] = bflo(xb.z); b0[5] = bfhi(xb.z); b0[6] = bflo(xb.w); b0[7] = bfhi(xb.w);
                float r[8];
#pragma unroll
                for (int e = 0; e < 8; ++e) { const float ca = ba[e] + wa[0][e] * a2[e] + wa[1][e] * a1[e] + wa[2][e] * a0[e];
                    const float cb = bb[e] + wb[0][e] * b2[e] + wb[1][e] * b1[e] + wb[2][e] * b0[e];
                    r[e] = gelu_as(ca) * cb; a2[e] = a1[e]; a1[e] = a0[e]; b2[e] = b1[e]; b1[e] = b0[e]; }
                u32x4 w; w.x = cvt_pk_bf16(r[0], r[1]); w.y = cvt_pk_bf16(r[2], r[3]); w.z = cvt_pk_bf16(r[4], r[5]); w.w = cvt_pk_bf16(r[6], r[7]);
                *(u32x4*)(ACT + (size_t)(t0 + i0 + j) * DFF + foff + c0) = w; }
        }
    }
}
__device__ __forceinline__ float log_sigmoid_(float z) { return (z >= 0.f) ? -log1pf(__expf(-z)) : (z - log1pf(__expf(z))); }
__device__ __forceinline__ void cumsum_task(int bh, const float* S, const float* b_f, float* CUM, LAS unsigned char* lds) {
    const int tid = otid(), lane = tid & 63, wid = tid >> 6, b = bh / 6, h = bh - b * 6; const float bf = b_f[h];
    const float* sp = S + ((size_t)b * SEQ + lane * 32) * 32 + 12 + h;
    LAS float* zb = (LAS float*)lds + wid * 2048 + lane;
#pragma unroll
    for (int i = 0; i < 32; ++i) zb[i * 64] = sp[(size_t)i * 32];
    float tot = 0.f;
#pragma unroll 1
    for (int i = 0; i < 32; ++i) { const float ls = log_sigmoid_(zb[i * 64] + bf); zb[i * 64] = ls; tot += ls; }
    float inc = tot;
#pragma unroll
    for (int off = 1; off < 64; off <<= 1) { const float o = __shfl_up(inc, off); if (lane >= off) inc += o; }
    float run = inc - tot;
    float* cp = CUM + (size_t)bh * SEQ + lane * 32;
#pragma unroll 4
    for (int i = 0; i < 32; ++i) { run += zb[i * 64]; cp[i] = run; }
}
__device__ __forceinline__ void cmp_mlp_unit(int unit, const Params& p, int layer, LAS unsigned char* lds) {
    char* const wsl = lp(p.ws);
    const int tid = otid(), wid = tid >> 6, lane = tid & 63, row = lane & 15, k8 = lane >> 4;
    const int c = unit >> 6, b = (unit >> 3) & 7, ng = unit & 7;
    const bf16_t* U = (const bf16_t*)(wsl + WS_RA + RA_U);
    const bf16_t* w1t = (const bf16_t*)(wsl + WS_W + W1_W1T) + (size_t)c * 128 * 4096;
    const bf16_t* w2t = (const bf16_t*)(wsl + WS_W + W1_W2T) + (size_t)c * 128 * 128;
    const float* b1p = (const float*)(wsl + WS_B1P) + c * 128;
    const float* b2 = p.cmp_b2 + (layer * 2 + c) * 128;
    bf16_t* KC = (bf16_t*)(wsl + WS_KC) + ((size_t)c * NBATCH + b) * 128 * 128;
    LAS bf16_t* hid = (LAS bf16_t*)lds;
    const int n = ng * 16 + row, nc = n < 126 ? n : 126;
    const bf16_t* arow = U + (size_t)(b * SEQ + 16 * nc) * U_LD + (c ? UC_VCMP : UC_KCMP) + 8 * k8;
    const bf16_t* brow = w1t + (size_t)(16 * wid + row) * 4096 + 8 * k8;
    f32x4 acc = {0.f, 0.f, 0.f, 0.f};
#pragma unroll 16
    for (int ks = 0; ks < 128; ++ks) {
        const bf16x8 a = *(const bf16x8*)(arow + (size_t)(ks >> 2) * U_LD + (ks & 3) * 32);
        const bf16x8 bb = *(const bf16x8*)(brow + ks * 32);
        acc = __builtin_amdgcn_mfma_f32_16x16x32_bf16(a, bb, acc, 0, 0, 0);
    }
    __syncthreads();
    { const int e = 16 * wid + row; const float bias = b1p[e];
#pragma unroll
      for (int j = 0; j < 4; ++j) hid[(k8 * 4 + j) * 136 + e] = f2bf(gelu_erf(acc[j] + bias)); }
    __syncthreads();
    f32x4 acc2 = {0.f, 0.f, 0.f, 0.f};
#pragma unroll
    for (int ks = 0; ks < 4; ++ks) {
        const bf16x8 a = *(const LAS bf16x8*)(hid + row * 136 + ks * 32 + 8 * k8);
        const bf16x8 bb = *(const bf16x8*)(w2t + (size_t)(16 * wid + row) * 128 + ks * 32 + 8 * k8);
        acc2 = __builtin_amdgcn_mfma_f32_16x16x32_bf16(a, bb, acc2, 0, 0, 0);
    }
    { const int e = 16 * wid + row; const float bias = b2[e];
#pragma unroll
      for (int j = 0; j < 4; ++j) { const int no = ng * 16 + k8 * 4 + j; KC[(size_t)no * 128 + e] = (no < 127) ? f2bf(acc2[j] + bias) : (bf16_t)0; } }
    __syncthreads();
}
constexpr int AT_K = 0, AT_KB = 64 * 272, AT_V = 2 * AT_KB, AT_VB = 128 * 144, AT_KI = AT_V + 2 * AT_VB, AT_LUT = AT_KI + 512, LUT_LD = 2052,
              AT_IMPW = AT_LUT + 4 * LUT_LD * 4, AT_IMPT = AT_IMPW + 32768, AT_MASK = AT_IMPT + 8192, AT_SC = AT_MASK + 256, AT_MISC = AT_SC + 2048, AT_END = AT_MISC + 64;
constexpr int LDS_BYTES = 150528;
static_assert(AT_END <= LDS_BYTES, "lds");
constexpr int BIGD = 1 << 28;

__device__ __forceinline__ int crow(int r, int hi) { return (r & 3) + 8 * (r >> 2) + 4 * hi; }
__device__ __forceinline__ unsigned wave_or(unsigned v) {
#pragma unroll
    for (int off = 32; off >= 1; off >>= 1) v |= (unsigned)__shfl_xor((int)v, off);
    return v; }
struct KVSrc { const bf16_t* k; const bf16_t* v; int ld, tok0, tstride; };
struct KVRegs { bf16x8 k0, k1, v0, v1; float kin; };

template <bool KIN>
__device__ __forceinline__ void kv_issue(KVRegs& R, const KVSrc& s, int kt, const float* cum) {
    const int tid = otid();
    { const int row = tid >> 3, c = (tid & 7) * 16; const bf16_t* kp = s.k + (size_t)(s.tok0 + (kt * 64 + row) * s.tstride) * s.ld + c;
      R.k0 = *(const bf16x8*)kp; R.k1 = *(const bf16x8*)(kp + 8); }
    { const int row = tid & 63, c = (tid >> 6) * 16; const bf16_t* vp = s.v + (size_t)(s.tok0 + (kt * 64 + row) * s.tstride) * s.ld + c;
      R.v0 = *(const bf16x8*)vp; R.v1 = *(const bf16x8*)(vp + 8); }
    if (KIN) { if (tid < 64) R.kin = cum[kt * 64 + tid] * LOG2E; }
}
template <bool KIN>
__device__ __forceinline__ void kv_commit(const KVRegs& R, LAS unsigned char* lds, int buf) {
    const int tid = otid();
    { const int row = tid >> 3, c = (tid & 7) * 16; LAS unsigned char* kp = lds + AT_K + buf * AT_KB + row * 272 + c * 2;
      *(LAS bf16x8*)kp = R.k0; *(LAS bf16x8*)(kp + 16) = R.k1; }
    { const int row = tid & 63, c = (tid >> 6) * 16, pos = (row & ~12) | ((row & 4) << 1) | ((row & 8) >> 1);
      LAS unsigned char* vp = lds + AT_V + buf * AT_VB + c * 144 + pos * 2;
#pragma unroll
      for (int i = 0; i < 8; ++i) { *(LAS short*)(vp + i * 144) = R.v0[i]; *(LAS short*)(vp + (8 + i) * 144) = R.v1[i]; } }
    if (KIN) { if (tid < 64) ((LAS float*)(lds + AT_KI))[buf * 64 + tid] = R.kin; }
}
__device__ __forceinline__ void qk_tile(LAS const unsigned char* kt, int r32, int hi, const bf16x8 (&qr)[8], f32x16& p0, f32x16& p1) {
#pragma unroll
    for (int r = 0; r < 16; ++r) { p0[r] = 0.f; p1[r] = 0.f; }
    LAS const unsigned char* a = kt + r32 * 272 + hi * 16;
    bf16x8 f0[8], f1[8];
#pragma unroll
    for (int d0 = 0; d0 < 8; ++d0) { f0[d0] = *(LAS const bf16x8*)(a + d0 * 32); f1[d0] = *(LAS const bf16x8*)(a + 32 * 272 + d0 * 32); }
    asm volatile("s_waitcnt lgkmcnt(8)" ::: "memory"); __builtin_amdgcn_sched_barrier(0);
    __builtin_amdgcn_s_setprio(1);
#pragma unroll
    for (int d0 = 0; d0 < 4; ++d0) { p0 = __builtin_amdgcn_mfma_f32_32x32x16_bf16(f0[d0], qr[d0], p0, 0, 0, 0); p1 = __builtin_amdgcn_mfma_f32_32x32x16_bf16(f1[d0], qr[d0], p1, 0, 0, 0); }
    __builtin_amdgcn_sched_barrier(0); asm volatile("s_waitcnt lgkmcnt(0)" ::: "memory"); __builtin_amdgcn_sched_barrier(0);
#pragma unroll
    for (int d0 = 4; d0 < 8; ++d0) { p0 = __builtin_amdgcn_mfma_f32_32x32x16_bf16(f0[d0], qr[d0], p0, 0, 0, 0); p1 = __builtin_amdgcn_mfma_f32_32x32x16_bf16(f1[d0], qr[d0], p1, 0, 0, 0); }
    __builtin_amdgcn_s_setprio(0);
}
__device__ __forceinline__ void pv_tile(LAS const unsigned char* vt, int r32, int hi, const bf16x8 (&pa)[4], f32x16 (&o)[4]) {
    LAS const unsigned char* a = vt + r32 * 144 + hi * 16;
    bf16x8 vf[16];
#pragma unroll
    for (int i = 0; i < 16; ++i) vf[i] = *(LAS const bf16x8*)(a + (i >> 2) * 32 * 144 + (i & 3) * 32);
    asm volatile("s_waitcnt lgkmcnt(8)" ::: "memory"); __builtin_amdgcn_sched_barrier(0);
    __builtin_amdgcn_s_setprio(1);
#pragma unroll
    for (int i = 0; i < 8; ++i) o[i >> 2] = __builtin_amdgcn_mfma_f32_32x32x16_bf16(pa[i & 3], vf[i], o[i >> 2], 0, 0, 0);
    __builtin_amdgcn_sched_barrier(0); asm volatile("s_waitcnt lgkmcnt(0)" ::: "memory"); __builtin_amdgcn_sched_barrier(0);
#pragma unroll
    for (int i = 8; i < 16; ++i) o[i >> 2] = __builtin_amdgcn_mfma_f32_32x32x16_bf16(pa[i & 3], vf[i], o[i >> 2], 0, 0, 0);
    __builtin_amdgcn_s_setprio(0);
}
__device__ __forceinline__ void pack_p(const f32x16& p0, const f32x16& p1, bf16x8 (&pa)[4]) {
#pragma unroll
    for (int s = 0; s < 4; ++s) { const f32x16& p = (s < 2) ? p0 : p1; const int r0 = 8 * (s & 1);
        u32x4 w; w.x = cvt_pk_bf16(p[r0], p[r0 + 1]); w.y = cvt_pk_bf16(p[r0 + 2], p[r0 + 3]); w.z = cvt_pk_bf16(p[r0 + 4], p[r0 + 5]); w.w = cvt_pk_bf16(p[r0 + 6], p[r0 + 7]);
        pa[s] = *reinterpret_cast<bf16x8*>(&w); }
}
__device__ __forceinline__ void scale_rows(f32x16 (&o)[4], float f, LAS float* sc, int r32, int hi) {
    sc[r32] = f;
    float fr[16];
#pragma unroll
    for (int r = 0; r < 16; ++r) fr[r] = sc[crow(r, hi)];
#pragma unroll
    for (int d0 = 0; d0 < 4; ++d0)
#pragma unroll
        for (int r = 0; r < 16; ++r) o[d0][r] *= fr[r];
}
constexpr int ST_SLICE = 8704;
static_assert(8 * ST_SLICE <= AT_KI, "staging slices must fit the K/V tile buffers");
template <class RowPtr>
__device__ __forceinline__ void store_rows_bf16(const f32x16 (&o)[4], LAS unsigned char* slice, int lane, RowPtr rp) {
    const int r32 = lane & 31, hi = lane >> 5;
#pragma unroll
    for (int r = 0; r < 16; ++r)
#pragma unroll
        for (int d0 = 0; d0 < 4; ++d0) *(LAS short*)(slice + crow(r, hi) * 272 + (d0 * 32 + r32) * 2) = (short)f2bf(o[d0][r]);
#pragma unroll
    for (int i = 0; i < 8; ++i) { const int c = lane + 64 * i, row = c >> 4, ch = c & 15;
        const u32x4 w = *(LAS const u32x4*)(slice + row * 272 + ch * 16);
        *(u32x4*)(rp(row) + ch * 8) = w; }
}
template <int MODE, class RowF, class RowB>
__device__ __forceinline__ void store_rows_f32(const f32x16 (&o)[4], LAS unsigned char* slice, int lane, RowF rf, RowB rb) {
    const int r32 = lane & 31, hi = lane >> 5;
#pragma unroll
    for (int half = 0; half < 2; ++half) {
#pragma unroll
        for (int rr = 0; rr < 8; ++rr)
#pragma unroll
            for (int d0 = 0; d0 < 4; ++d0) *(LAS float*)(slice + (crow(8 * half + rr, hi) - 16 * half) * 528 + (d0 * 32 + r32) * 4) = o[d0][8 * half + rr];
#pragma unroll
        for (int i = 0; i < 8; ++i) { const int c = lane + 64 * i, rowl = c >> 5, ch = c & 31, row = 16 * half + rowl;
            const f32x4 v = *(LAS const f32x4*)(slice + rowl * 528 + ch * 16);
            if (MODE == 0) *(f32x4*)(rf(row) + ch * 4) = v;
            else if (MODE == 1) { float* q = rf(row) + ch * 4; *(f32x4*)q = *(const f32x4*)q + v; }
            else { const f32x4 t = *(const f32x4*)(rf(row) + ch * 4) + v; u32x2 w; w.x = cvt_pk_bf16(t[0], t[1]); w.y = cvt_pk_bf16(t[2], t[3]); *(u32x2*)(rb(row) + ch * 4) = w; } }
    }
}
template <int TYPE>
__device__ __forceinline__ void attn_pass(LAS unsigned char* lds, const KVSrc& src, unsigned tilemask, const float* cum,
                                          const bf16x8 (&qr)[8], int qi, bool row_valid, int qw_lo, int qw_hi, bool wave_valid, int maxd, int lutmax,
                                          unsigned selmask, float cq, int lutrow, f32x16 (&o)[4], float& m, float& l) {
    const int tid = otid(), wid = tid >> 6, lane = tid & 63, r32 = lane & 31, hi = lane >> 5;
    LAS float* sc = (LAS float*)(lds + AT_SC) + wid * 64;
    LAS const float* lut = (LAS const float*)(lds + AT_LUT) + lutrow * LUT_LD;
    const float NEG = -__builtin_inff();
#pragma unroll
    for (int d0 = 0; d0 < 4; ++d0)
#pragma unroll
        for (int r = 0; r < 16; ++r) o[d0][r] = 0.f;
    m = -1e30f; l = 0.f;
    const unsigned wsel = (TYPE == 2) ? wave_or(selmask) : 0xffffffffu;
    KVRegs R;
    unsigned tm = tilemask;
    int kt = __ffs(tm) - 1; tm &= tm - 1;
    kv_issue<TYPE == 0>(R, src, kt, cum);
    __syncthreads();
    kv_commit<TYPE == 0>(R, lds, 0);
    __syncthreads();
    int buf = 0;
    for (;;) {
        const int nk = tm ? (__ffs(tm) - 1) : -1;
        if (nk >= 0) { tm &= tm - 1; kv_issue<TYPE == 0>(R, src, nk, cum); }
        const bool act = wave_valid && (64 * kt <= qw_hi) && (64 * kt + 63 >= qw_lo - maxd) && ((wsel >> kt) & 1u);
        if (act) {
            f32x16 p0, p1;
            qk_tile(lds + AT_K + buf * AT_KB, r32, hi, qr, p0, p1);
            LAS const float* kin = (LAS const float*)(lds + AT_KI) + buf * 64;
            const bool rok = row_valid && ((TYPE != 2) || ((selmask >> kt) & 1u));
            const bool interior = (TYPE != 2) && (64 * kt + 63 <= qw_lo) && (64 * kt >= qw_hi - maxd);
            const int qb = qi - kt * 64 - 4 * hi;
            constexpr float C2 = ATT_SCALE * LOG2E;
            float mx = NEG;
            if (TYPE == 0) {
#define MOD_HALF(P, H32) _Pragma("unroll") for (int g = 0; g < 4; ++g) { const f32x4 kv = *(LAS const f32x4*)(kin + 32 * (H32) + 4 * hi + 8 * g); \
                _Pragma("unroll") for (int i = 0; i < 4; ++i) { const int r = 4 * g + i; float v = fmaf(P[r], C2, cq - kv[i]); \
                    if (!interior) { const int dq = qb - (32 * (H32) + i + 8 * g); v = (rok && dq >= 0) ? v : NEG; } \
                    P[r] = v; mx = fmaxf(mx, v); } }
                MOD_HALF(p0, 0) MOD_HALF(p1, 1)
#undef MOD_HALF
            } else {
                LAS const float* lq = lut + (qb - 63);
#define MOD_HALF(P, H32) _Pragma("unroll") for (int r = 0; r < 16; ++r) { const int c = 32 * (H32) + (r & 3) + 8 * (r >> 2); \
                    float v = fmaf(P[r], C2, lq[63 - c]); \
                    if (!interior) { const int dq = qb - c; v = (rok && ((unsigned)dq <= (unsigned)maxd)) ? v : NEG; } \
                    P[r] = v; mx = fmaxf(mx, v); }
                MOD_HALF(p0, 0) MOD_HALF(p1, 1)
#undef MOD_HALF
            }
            { const auto rr = __builtin_amdgcn_permlane32_swap(__float_as_uint(mx), __float_as_uint(mx), false, false); mx = fmaxf(__uint_as_float(rr[0]), __uint_as_float(rr[1])); }
            constexpr float THR = 8.0f;
            float mn, alpha; bool resc;
            if (__all(mx - m <= THR)) { mn = m; alpha = 1.0f; resc = false; }
            else { mn = fmaxf(m, mx); alpha = __builtin_amdgcn_exp2f(m - mn); resc = true; }
            float ps = 0.f;
#pragma unroll
            for (int r = 0; r < 16; ++r) { p0[r] = __builtin_amdgcn_exp2f(p0[r] - mn); p1[r] = __builtin_amdgcn_exp2f(p1[r] - mn); ps += p0[r] + p1[r]; }
            { const auto rr = __builtin_amdgcn_permlane32_swap(__float_as_uint(ps), __float_as_uint(ps), false, false); ps = __uint_as_float(rr[0]) + __uint_as_float(rr[1]); }
            l = l * alpha + ps; m = mn;
            if (resc) scale_rows(o, alpha, sc, r32, hi);
            bf16x8 pa[4]; pack_p(p0, p1, pa);
            pv_tile(lds + AT_V + buf * AT_VB, r32, hi, pa, o);
        }
        if (nk < 0) break;
        kv_commit<TYPE == 0>(R, lds, buf ^ 1);
        __syncthreads();
        buf ^= 1; kt = nk;
    }
    __syncthreads();
}
__device__ __forceinline__ void load_q(const bf16_t* qp, int hi, bf16x8 (&qr)[8]) {
#pragma unroll
    for (int d0 = 0; d0 < 8; ++d0) qr[d0] = *(const bf16x8*)(qp + d0 * 16 + hi * 8);
}
__device__ __forceinline__ unsigned bits_range(int lo, int hi) { return (0xffffffffu >> (31 - hi)) & (0xffffffffu << lo); }

__device__ __forceinline__ void fox_item(int b, int h, int qt, const Params& p, LAS unsigned char* lds) {
    char* const wsl = lp(p.ws);
    const int tid = otid(), wid = tid >> 6, lane = tid & 63, r32 = lane & 31, hi = lane >> 5;
    const bf16_t* U = (const bf16_t*)(wsl + WS_RA + RA_U); bf16_t* OALL = (bf16_t*)(wsl + WS_ZX + ZX_OALL);
    const float* cum = (const float*)(wsl + WS_CUM) + (size_t)(b * 6 + h) * SEQ;
    const int t0 = qt * 256, qi = t0 + wid * 32 + r32;
    bf16x8 qr[8]; load_q(U + (size_t)(b * SEQ + qi) * U_LD + UC_CQ + h * 128, hi, qr);
    KVSrc src; src.k = U + UC_CK + h * 128; src.v = U + UC_CV + h * 128; src.ld = U_LD; src.tok0 = b * SEQ; src.tstride = 1;
    f32x16 o[4]; float m, l;
    attn_pass<0>(lds, src, bits_range(0, 4 * qt + 3), cum, qr, qi, true, t0 + wid * 32, t0 + wid * 32 + 31, true, BIGD, 0, 0u, cum[qi] * LOG2E, 0, o, m, l);
    LAS float* sc = (LAS float*)(lds + AT_SC) + wid * 64;
    scale_rows(o, 1.0f / l, sc, r32, hi);
    { bf16_t* ob = lv(OALL + (size_t)(b * SEQ + t0 + wid * 32) * OA_LD + 768 + h * 128);
      store_rows_bf16(o, lds + AT_K + wid * ST_SLICE, lane, [&](int row) { return ob + (size_t)row * OA_LD; }); }
}
__device__ __forceinline__ void dil_item(int g, int b, int hh, int res, int it, const Params& p, LAS unsigned char* lds) {
    char* const wsl = lp(p.ws);
    const int tid = otid(), wid = tid >> 6, lane = tid & 63, r32 = lane & 31, hi = lane >> 5;
    const bf16_t* U = (const bf16_t*)(wsl + WS_RA + RA_U);
    float* OAP = (float*)(wsl + WS_ZX + ZX_OAP) + (size_t)g * T_TOK * 256; float* LSE = (float*)(wsl + WS_LSE) + (size_t)g * T_TOK * 2;
    const int dil = g == 0 ? 1 : (g == 1 ? 4 : 16), L = SEQ / dil, head = 2 * g + hh, i0 = it * 256, nrows = (L - i0) < 256 ? (L - i0) : 256;
    LAS float* lut = (LAS float*)(lds + AT_LUT);
    if (tid <= 128) lut[tid] = ((const float*)(wsl + WS_BLA))[head * 132 + tid];
    const int slot = wid * 32 + r32; const bool rv = slot < nrows; const int qi = i0 + (rv ? slot : 0);
    bf16x8 qr[8]; load_q(U + (size_t)(b * SEQ + res + dil * qi) * U_LD + UC_AQ + head * 128, hi, qr);
    KVSrc src; src.k = U + UC_AK + head * 128; src.v = U + UC_AV + head * 128; src.ld = U_LD; src.tok0 = b * SEQ + res; src.tstride = dil;
    const int klo = (i0 - 128) > 0 ? (i0 - 128) : 0, khi = ((i0 + 256) < L ? (i0 + 256) : L) - 1;
    f32x16 o[4]; float m, l;
    __syncthreads();
    attn_pass<1>(lds, src, bits_range(klo >> 6, khi >> 6), nullptr, qr, qi, rv, i0 + wid * 32, i0 + wid * 32 + 31, wid * 32 < nrows, 128, 128, 0u, 0.f, 0, o, m, l);
    LAS float* sc = (LAS float*)(lds + AT_SC) + wid * 64;
    scale_rows(o, rv ? 1.0f / l : 0.f, sc, r32, hi);
    if (wid * 32 < nrows) {
        if (hi == 0 && rv) LSE[(size_t)(b * SEQ + res + dil * qi) * 2 + hh] = (m + log2f(l)) * LN2;
        float* ob = lv(OAP + (size_t)(b * SEQ + res + dil * (i0 + wid * 32)) * 256 + hh * 128);
        store_rows_f32<0>(o, lds + AT_K + wid * ST_SLICE, lane, [&](int row) { return ob + (size_t)row * dil * 256; }, [&](int) { return (bf16_t*)nullptr; });
    }
}
__device__ __forceinline__ void mergeA_item(int item, const Params& p) {
    char* const wsl = lp(p.ws);
    const int tid = otid(), tok = item * 256 + (tid >> 1), hh = tid & 1;
    const float* OAP = (const float*)(wsl + WS_ZX + ZX_OAP); const float* LSE = (const float*)(wsl + WS_LSE); bf16_t* OALL = (bf16_t*)(wsl + WS_ZX + ZX_OALL);
    const float l0 = LSE[(size_t)tok * 2 + hh], l1 = LSE[(size_t)(T_TOK + tok) * 2 + hh], l2 = LSE[(size_t)(2 * T_TOK + tok) * 2 + hh];
    const float mx = fmaxf(l0, fmaxf(l1, l2)), e0 = __expf(l0 - mx), e1 = __expf(l1 - mx), e2 = __expf(l2 - mx), inv = 1.0f / (e0 + e1 + e2);
    const float w0 = e0 * inv, w1 = e1 * inv, w2 = e2 * inv;
    const float* a0 = OAP + (size_t)tok * 256 + hh * 128; const float* a1 = a0 + (size_t)T_TOK * 256; const float* a2 = a1 + (size_t)T_TOK * 256;
    bf16_t* op = OALL + (size_t)tok * OA_LD + hh * 128;
#pragma unroll 4
    for (int d = 0; d < 128; d += 4) { const f32x4 v = *(const f32x4*)(a0 + d) * w0 + *(const f32x4*)(a1 + d) * w1 + *(const f32x4*)(a2 + d) * w2;
        u32x2 w; w.x = cvt_pk_bf16(v[0], v[1]); w.y = cvt_pk_bf16(v[2], v[3]); *(u32x2*)(op + d) = w; }
}
__device__ __forceinline__ void nsa_item(int b, int tt, const Params& p, int layer, LAS unsigned char* lds) {
    char* const wsl = lp(p.ws);
    const int tid = otid(), wid = tid >> 6, lane = tid & 63, r32 = lane & 31, hi = lane >> 5;
    const bf16_t* U = (const bf16_t*)(wsl + WS_RA + RA_U); bf16_t* OALL = (bf16_t*)(wsl + WS_ZX + ZX_OALL); float* OBT = (float*)(wsl + WS_ZX + ZX_OBT);
    const float* S = (const float*)(wsl + WS_S); const bf16_t* KC = (const bf16_t*)(wsl + WS_KC);
    const int head = wid >> 1, t0 = tt * 64, tl = (wid & 1) * 32 + r32, qi = t0 + tl, row = b * SEQ + qi;
    LAS float* lutall = (LAS float*)(lds + AT_LUT);
    { const float* blb = (const float*)(wsl + WS_BLB);
#pragma unroll 4
      for (int i = tid; i < 4 * LUT_LD; i += 512) lutall[i] = blb[i]; }
    bf16x8 qr[8]; load_q(U + (size_t)row * U_LD + UC_BQ + head * 128, hi, qr);
    const float* bg = p.b_nsa_gate + layer * 12;
    const float g0 = sigmoidf_(S[(size_t)row * 32 + head] + bg[head]), g1 = sigmoidf_(S[(size_t)row * 32 + 4 + head] + bg[4 + head]), g2 = sigmoidf_(S[(size_t)row * 32 + 8 + head] + bg[8 + head]);
    LAS float* sc = (LAS float*)(lds + AT_SC) + wid * 64;
    LAS const float* lut = lutall + head * LUT_LD;
    f32x16 o[4];
    { KVSrc src; src.k = KC + (size_t)b * 128 * 128; src.v = KC + (size_t)(NBATCH + b) * 128 * 128; src.ld = 128; src.tok0 = 0; src.tstride = 1;
      KVRegs R; kv_issue<false>(R, src, 0, nullptr); kv_commit<false>(R, lds, 0); kv_issue<false>(R, src, 1, nullptr); kv_commit<false>(R, lds, 1); }
    __syncthreads();
    {
        f32x16 pa0, pa1, pb0, pb1;
        qk_tile(lds + AT_K, r32, hi, qr, pa0, pa1); qk_tile(lds + AT_K + AT_KB, r32, hi, qr, pb0, pb1);
        const float NEG = -__builtin_inff(); float mx = NEG;
#define CMP_MOD(P, Q4) _Pragma("unroll") for (int r = 0; r < 16; ++r) { \
                const int n = 32 * (Q4) + crow(r, hi), dc = qi - (16 * n + 31); \
                const bool ok = dc >= 0 && n < 127; \
                const float s = fmaf(P[r], ATT_SCALE * LOG2E, lut[dc < 0 ? 0 : dc]); \
                const float v = ok ? s : NEG; P[r] = v; mx = fmaxf(mx, v); }
        CMP_MOD(pa0, 0) CMP_MOD(pa1, 1) CMP_MOD(pb0, 2) CMP_MOD(pb1, 3)
#undef CMP_MOD
        mx = fmaxf(mx, __shfl_xor(mx, 32));
        float ps = 0.f;
#pragma unroll
        for (int r = 0; r < 16; ++r) {
            pa0[r] = (pa0[r] == NEG) ? 0.f : __builtin_amdgcn_exp2f(pa0[r] - mx); pa1[r] = (pa1[r] == NEG) ? 0.f : __builtin_amdgcn_exp2f(pa1[r] - mx);
            pb0[r] = (pb0[r] == NEG) ? 0.f : __builtin_amdgcn_exp2f(pb0[r] - mx); pb1[r] = (pb1[r] == NEG) ? 0.f : __builtin_amdgcn_exp2f(pb1[r] - mx);
            ps += (pa0[r] + pa1[r]) + (pb0[r] + pb1[r]); }
        ps += __shfl_xor(ps, 32);
        const float inv = ps > 0.f ? 1.0f / ps : 0.f;
        {
            float mainv[16], extra[16];
#pragma unroll
            for (int idx = 0; idx < 16; ++idx) { const int q4 = idx >> 2, gq = idx & 3;
                const f32x16& pp = (q4 == 0) ? pa0 : (q4 == 1) ? pa1 : (q4 == 2) ? pb0 : pb1;
                mainv[idx] = ((pp[4 * gq] + pp[4 * gq + 1]) + (pp[4 * gq + 2] + pp[4 * gq + 3])) * inv; extra[idx] = pp[4 * gq + 3] * inv; }
            LAS float* impw = (LAS float*)(lds + AT_IMPW) + (wid * 32 + r32) * 32;
#pragma unroll
            for (int idx = 0; idx < 16; ++idx) { const float eo = __shfl_xor(extra[idx], 32); const float eprev = (idx > 0) ? __shfl_xor(extra[idx > 0 ? idx - 1 : 0], 32) : 0.f;
                impw[2 * idx + hi] = mainv[idx] + (hi ? eo : eprev); }
        }
        bf16x8 pkA[4], pkB[4];
        pack_p(pa0, pa1, pkA); pack_p(pb0, pb1, pkB);
        asm volatile("" ::: "memory");
#pragma unroll
        for (int d0 = 0; d0 < 4; ++d0)
#pragma unroll
            for (int r = 0; r < 16; ++r) o[d0][r] = 0.f;
        pv_tile(lds + AT_V, r32, hi, pkA, o);
        pv_tile(lds + AT_V + AT_VB, r32, hi, pkB, o);
        scale_rows(o, g0 * inv, sc, r32, hi);
        { float* ob = lv(OBT + (size_t)(b * SEQ + t0 + (wid & 1) * 32 + 4 * hi) * 512 + head * 128 + r32);
#pragma unroll
        for (int r = 0; r < 16; ++r) { float* op = ob + ((r & 3) + 8 * (r >> 2)) * 512;
#pragma unroll
            for (int d0 = 0; d0 < 4; ++d0) op[d0 * 32] = o[d0][r]; } }
    }
    __syncthreads();
    { const int tk = tid >> 3, jq = tid & 7; LAS const float* iw = (LAS const float*)(lds + AT_IMPW); LAS float* it = (LAS float*)(lds + AT_IMPT);
#pragma unroll
      for (int e = 0; e < 4; ++e) { const int j = 4 * jq + e; float s = 0.f;
#pragma unroll
          for (int h = 0; h < 4; ++h) s += iw[((2 * h + (tk >> 5)) * 32 + (tk & 31)) * 32 + j];
          it[tk * 32 + j] = s; } }
    __syncthreads();
    { const int tk = tid >> 3, jq = tid & 7; LAS const float* it = (LAS const float*)(lds + AT_IMPT) + tk * 32;
      float scv[32];
#pragma unroll
      for (int j = 0; j < 32; ++j) scv[j] = (j == 0 || j == tt || j == tt - 1) ? 1e9f : (j <= tt ? it[j] : -1e30f);
      unsigned bits = 0;
#pragma unroll
      for (int e = 0; e < 4; ++e) { const int j = 4 * jq + e; float sj = scv[0];
#pragma unroll
          for (int i = 1; i < 32; ++i) sj = (i == j) ? scv[i] : sj;
          int rank = 0;
#pragma unroll
          for (int i = 0; i < 32; ++i) rank += (scv[i] > sj || (scv[i] == sj && i < j)) ? 1 : 0;
          if (rank < 16) bits |= 1u << j; }
      bits |= (unsigned)__shfl_xor((int)bits, 1); bits |= (unsigned)__shfl_xor((int)bits, 2); bits |= (unsigned)__shfl_xor((int)bits, 4);
      if (jq == 0) ((LAS unsigned*)(lds + AT_MASK))[tk] = bits; }
    __syncthreads();
    const unsigned selmask = ((LAS const unsigned*)(lds + AT_MASK))[tl];
    const unsigned allsel = wave_or(((LAS const unsigned*)(lds + AT_MASK))[lane]);
    float m, l;
    { KVSrc src; src.k = U + UC_KSLC; src.v = U + UC_VSLC; src.ld = U_LD; src.tok0 = b * SEQ; src.tstride = 1;
      attn_pass<2>(lds, src, allsel & bits_range(0, tt), nullptr, qr, qi, true, t0 + (wid & 1) * 32, t0 + (wid & 1) * 32 + 31, true, BIGD, 2048, selmask, 0.f, head, o, m, l);
      scale_rows(o, g1 / l, sc, r32, hi);
      float* ob = lv(OBT + (size_t)(b * SEQ + t0 + (wid & 1) * 32) * 512 + head * 128);
      store_rows_f32<1>(o, lds + AT_K + wid * ST_SLICE, lane, [&](int row) { return ob + (size_t)row * 512; }, [&](int) { return (bf16_t*)nullptr; }); }
    { KVSrc src; src.k = U + UC_KWIN; src.v = U + UC_VWIN; src.ld = U_LD; src.tok0 = b * SEQ; src.tstride = 1;
      attn_pass<3>(lds, src, bits_range(tt > 8 ? tt - 8 : 0, tt), nullptr, qr, qi, true, t0 + (wid & 1) * 32, t0 + (wid & 1) * 32 + 31, true, 511, 511, 0u, 0.f, head, o, m, l);
      scale_rows(o, g2 / l, sc, r32, hi);
      float* tb = lv(OBT + (size_t)(b * SEQ + t0 + (wid & 1) * 32) * 512 + head * 128);
      bf16_t* obb = lv(OALL + (size_t)(b * SEQ + t0 + (wid & 1) * 32) * OA_LD + 256 + head * 128);
      store_rows_f32<2>(o, lds + AT_K + wid * ST_SLICE, lane, [&](int row) { return tb + (size_t)row * 512; }, [&](int row) { return obb + (size_t)row * OA_LD; }); }
}
__device__ __forceinline__ int next_item(unsigned* ctr, LAS unsigned char* lds) {
    LAS int* slot = (LAS int*)(lds + AT_MISC);
    __syncthreads();
    if (threadIdx.x == 0) *slot = (int)atomicAdd(ctr, 1u);
    __syncthreads();
    return *slot;
}
#ifndef LOCKSTEP
#define LOCKSTEP 0
#endif
template <class Epi>
__device__ __forceinline__ void run_gemm(LAS unsigned char* lds, const bf16_t* A, int lda, const bf16_t* Bt, int ldb, int N, int K, const Epi& E, unsigned* lockstep = nullptr) {
    pg8::Gemm g; g.A = lp(A); g.Bt = lp(Bt); g.M = T_TOK; g.N = li(N); g.K = li(K); g.lda = li(lda); g.ldb = li(ldb); N = g.N;
    pg8::StaticOrder S; S.init(T_TOK, N, gridDim.x, blockIdx.x, Epi::NSEG);
    pg8::gemm_phase<Epi>(lds, g, S, E, lockstep);
}

#define ws (lp(p.ws))
#define XB ((bf16_t*)(ws + WS_XB))
#define ZX ((float*)(ws + WS_ZX))
#define Ubuf ((bf16_t*)(ws + WS_RA + RA_U))
#define Gbuf ((bf16_t*)(ws + WS_RA + RA_G))
#define Hbuf ((bf16_t*)(ws + WS_RA + RA_H))
#define ACT ((bf16_t*)(ws + WS_RA + RA_ACT))
#define Sbuf ((float*)(ws + WS_S))
#define ctr ((unsigned*)(ws + WS_CTR))
#define SYNC() xcd_barrier(xb)
template <int layer>
__device__ __forceinline__ void layer_body(const Params& p, LAS unsigned char* lds, const XcdBarrier& xb) {
    const int wid = otid() >> 6;
        const float* xin = layer == 0 ? p.x : p.out;
        { pg8::Epi1 E; E.U = Ubuf; E.G = Gbuf; E.S = Sbuf; E.b_gate = p.b_gate + (size_t)layer * 6144;
          run_gemm(lds, XB, KLD, (const bf16_t*)(ws + WS_W + W1_BT1), KLD, N1, DM, E, LOCKSTEP ? ctr + 8 + layer * 4 : nullptr); }
        SYNC();
        for (;;) { const int i = next_item(ctr + (layer * 2 + 0) * 64, lds); if (i >= 646) break;
            if (i < 128) cmp_mlp_unit(i, p, layer, lds);
            else if (i < 134) { cumsum_task((i - 128) * 8 + wid, Sbuf, p.b_f + layer * 6, (float*)(ws + WS_CUM), lds); }
            else if (i < 262) { const int j = i - 134; dil_item(0, j >> 4, (j >> 3) & 1, 0, j & 7, p, lds); }
            else if (i < 390) { const int j = i - 262; dil_item(1, j >> 4, (j >> 3) & 1, (j >> 1) & 3, j & 1, p, lds); }
            else { const int j = i - 390; dil_item(2, j >> 5, (j >> 4) & 1, j & 15, 0, p, lds); } }
        SYNC();
        for (;;) { const int i = next_item(ctr + (layer * 2 + 1) * 64, lds); if (i >= 704) break;
            if (i < 640) {
                int fox_qt = -1, fox_w = 0, nsa_tt = 0, nsa_b = 0;
                if (i < 160) { nsa_tt = 31 - (i >> 3); nsa_b = i & 7; }
                else if (i < 352) { const int j = i - 160; fox_qt = 7 - j / 48; fox_w = j % 48; }
                else if (i < 384) { const int j = i - 352; nsa_tt = 11 - (j >> 3); nsa_b = j & 7; }
                else if (i < 432) { fox_qt = 3; fox_w = i - 384; }
                else if (i < 464) { const int j = i - 432; nsa_tt = 7 - (j >> 3); nsa_b = j & 7; }
                else if (i < 560) { const int j = i - 464; fox_qt = 2 - j / 48; fox_w = j % 48; }
                else if (i < 592) { const int j = i - 560; nsa_tt = 3 - (j >> 3); nsa_b = j & 7; }
                else { fox_qt = 0; fox_w = i - 592; }
                if (fox_qt >= 0) fox_item(fox_w / 6, fox_w % 6, fox_qt, p, lds);
                else nsa_item(nsa_b, nsa_tt, p, layer, lds); }
            else mergeA_item(i - 640, p); }
        SYNC();
        { pg8::Epi2 E; E.G = Gbuf; E.O = XB; E.T = (bf16_t*)(ws + WS_RA + RA_U);
          run_gemm(lds, (const bf16_t*)(ws + WS_ZX + ZX_OALL), OA_LD, (const bf16_t*)(ws + WS_W + W1_BTP), OA_LD, DM, OA_LD, E); }
        SYNC();
        { pg8::EpiRes E; E.R = xin; E.Z = ZX;
          run_gemm(lds, XB, KLD, (const bf16_t*)(ws + WS_W + W1_BTOUT), KLD, DM, DM, E); }
        SYNC();
        ln_phase<true>(ZX, ZX, XB, p.ln1_g + (size_t)layer * DM, p.ln1_b + (size_t)layer * DM);
        convert_phase(p, layer, 2, lds);

        SYNC();
        { pg8::EpiH E; E.H = Hbuf; E.ldh = 2 * FFA;
          run_gemm(lds, XB, KLD, (const bf16_t*)(ws + WS_W + W2_BTUP), KLD, 2 * FFA, DM, E, LOCKSTEP ? ctr + 9 + layer * 4 : nullptr); }
        SYNC();
        conv_phase(Hbuf, FFA, 0, p.conv_w + (size_t)layer * 3 * 2 * DFF, p.conv_b + (size_t)layer * 2 * DFF, ACT);
        SYNC();
        { pg8::EpiH E; E.H = Hbuf; E.ldh = 2 * FFB;
          run_gemm(lds, XB, KLD, (const bf16_t*)(ws + WS_W + W2_BTUP) + (size_t)2 * FFA * KLD, KLD, 2 * FFB, DM, E, LOCKSTEP ? ctr + 10 + layer * 4 : nullptr); }
        SYNC();
        conv_phase(Hbuf, FFB, FFA, p.conv_w + (size_t)layer * 3 * 2 * DFF, p.conv_b + (size_t)layer * 2 * DFF, ACT);
        SYNC();
        { pg8::EpiRes E; E.R = ZX; E.Z = ZX;
          run_gemm(lds, ACT, DFF, (const bf16_t*)(ws + WS_W + W2_BTDN), DFF, DM, DFF, E); }
        SYNC();
        ln_phase<(layer + 1 < NLAYER)>(ZX, p.out, XB, p.ln2_g + (size_t)layer * DM, p.ln2_b + (size_t)layer * DM);
        if (layer + 1 < NLAYER) { convert_phase(p, layer + 1, 1, lds); b1p_phase(p, layer + 1); SYNC(); }
}
__global__ void __launch_bounds__(512, 2) hybrid_fwd(Params p) {
    extern __shared__ __attribute__((aligned(16))) unsigned char lds_raw[];
    LAS unsigned char* lds = (LAS unsigned char*)lds_raw;
    cg::grid_group grid = cg::this_grid();
    if (threadIdx.x == 0) { ((LAS unsigned*)(lds + AT_MISC))[4] = 0u; ((LAS unsigned*)(lds + AT_MISC))[5] = 0u; }
    __syncthreads();
    const XcdBarrier xb = xcd_barrier_post((unsigned*)(ws + WS_BAR), (volatile LAS unsigned*)(lds + AT_MISC + 16));
    convert_phase(p, 0, 1, lds); b1p_phase(p, 0); bucket_phase(p); xcvt_phase(p.x, XB);
    if (p.never) grid.sync();
    SYNC();
    layer_body<0>(p, lds, xb);
    layer_body<1>(p, lds, xb);
}
#undef ws
#undef XB
#undef ZX
#undef Ubuf
#undef Gbuf
#undef Hbuf
#undef ACT
#undef Sbuf
#undef ctr
#undef SYNC

extern "C" void kernel_launch(void* const* d_in, const int* in_sizes, int n_in, void* d_out, int out_size, void* d_ws, size_t ws_size, hipStream_t stream) {
    static int grid_blocks = 0;
    if (!grid_blocks) {
        int dev = 0, cus = 0, per_cu = 0;
        (void)hipGetDevice(&dev);
        (void)hipDeviceGetAttribute(&cus, hipDeviceAttributeMultiprocessorCount, dev);
        if (hipFuncSetAttribute((const void*)hybrid_fwd, hipFuncAttributeMaxDynamicSharedMemorySize, LDS_BYTES) != hipSuccess) fprintf(stderr, "hipFuncSetAttribute failed\n");
        (void)hipOccupancyMaxActiveBlocksPerMultiprocessor(&per_cu, hybrid_fwd, 512, LDS_BYTES);
        if (per_cu < 1) per_cu = 1;
        if (cus <= 0) cus = 256;
        grid_blocks = cus * per_cu;
        fprintf(stderr, "grid %d (cus %d per_cu %d) ws %zu need %zu\n", grid_blocks, cus, per_cu, ws_size, (size_t)WS_TOTAL);
    }
    if (ws_size < WS_TOTAL || n_in < 24) { fprintf(stderr, "workspace too small / bad inputs\n"); return; }
    Params p{};
    const float* const* in = (const float* const*)d_in;
    p.x = in[0]; p.rel_bias = in[1]; p.w_in = in[2]; p.b_f = in[3]; p.b_nsa_gate = in[4]; p.cmp_pe = in[5]; p.cmp_w1 = in[6]; p.cmp_b1 = in[7];
    p.cmp_w2 = in[8]; p.cmp_b2 = in[9]; p.w_gate = in[10]; p.b_gate = in[11]; p.w_pa = in[12]; p.w_pb = in[13]; p.w_pc = in[14]; p.w_out = in[15];
    p.ln1_g = in[16]; p.ln1_b = in[17]; p.w_up = in[18]; p.conv_w = in[19]; p.conv_b = in[20]; p.w_down = in[21]; p.ln2_g = in[22]; p.ln2_b = in[23];
    p.out = (float*)d_out; p.ws = (char*)d_ws; p.never = 0; p.pad = 0;
    (void)hipMemsetAsync((char*)d_ws + WS_CTR, 0, 1024 + 16384, stream);
    void* args[] = {&p};
    hipError_t e = hipLaunchCooperativeKernel((void*)hybrid_fwd, dim3(grid_blocks), dim3(512), args, LDS_BYTES, stream);
    if (e != hipSuccess) fprintf(stderr, "cooperative launch failed: %s (grid %d)\n", hipGetErrorString(e), grid_blocks);
}
```

```cpp
#include <hip/hip_runtime.h>
#include <hip/hip_cooperative_groups.h>
#include <cstdio>
#include <cstdint>
namespace cg = cooperative_groups;

#define LAS __attribute__((address_space(3)))
typedef unsigned short bf16_t;
typedef short bf16x8 __attribute__((ext_vector_type(8)));
typedef short s16x4 __attribute__((ext_vector_type(4)));
typedef float f32x2 __attribute__((ext_vector_type(2)));
typedef float f32x4 __attribute__((ext_vector_type(4)));
typedef float f32x16 __attribute__((ext_vector_type(16)));
typedef unsigned u32x2 __attribute__((ext_vector_type(2)));
typedef unsigned u32x4 __attribute__((ext_vector_type(4)));

constexpr int T_TOK = 16384, SEQ = 2048, DM = 2048, NBATCH = 8, NLAYER = 2;
constexpr int NIN = 5906, U_LD = 5888, G_LD = 6144, N1 = 12288, DFF = 5632;
constexpr int UC_AQ = 0, UC_AK = 768, UC_AV = 1536, UC_BQ = 2304, UC_CQ = 2816, UC_CK = 3584, UC_CV = 4352,
              UC_KSLC = 5120, UC_VSLC = 5248, UC_KWIN = 5376, UC_VWIN = 5504, UC_KCMP = 5632, UC_VCMP = 5760;
constexpr int KLD = 2048 + 64;
constexpr int OA_LD = 1536;
constexpr int FFA = 3072, FFB = 2560;
constexpr float ALPHA = 1.41421356237309515f;
constexpr float LN_EPS = 1e-5f;
constexpr float ATT_SCALE = 0.08838834764831845f;
constexpr float LOG2E = 1.4426950408889634f, LN2 = 0.6931471805599453f;

constexpr size_t AL(size_t x) { return (x + 255) & ~(size_t)255; }
constexpr size_t WS_W = 0;
constexpr size_t W1_BT1 = 0;
constexpr size_t W1_BTP = W1_BT1 + (size_t)N1 * KLD * 2;
constexpr size_t W1_BTOUT = W1_BTP + (size_t)2048 * 1536 * 2;
constexpr size_t W1_W1T = W1_BTOUT + (size_t)2048 * KLD * 2;
constexpr size_t W1_W2T = W1_W1T + (size_t)2 * 128 * 4096 * 2;
constexpr size_t W1_END = W1_W2T + (size_t)2 * 128 * 128 * 2;
constexpr size_t W2_BTUP = 0;
constexpr size_t W2_BTDN = W2_BTUP + (size_t)11264 * KLD * 2;
constexpr size_t W2_END = W2_BTDN + (size_t)2048 * 5632 * 2;
constexpr size_t WS_W_SIZE = AL(W1_END > W2_END ? W1_END : W2_END);
constexpr size_t WS_RA = WS_W + WS_W_SIZE;
constexpr size_t RA_U = 0, RA_G = (size_t)T_TOK * U_LD * 2;
constexpr size_t RA_SIZE = RA_G + (size_t)T_TOK * G_LD * 2;
constexpr size_t RA_H = 0, RA_ACT = (size_t)T_TOK * 6144 * 2;
static_assert(RA_ACT + (size_t)T_TOK * DFF * 2 <= RA_SIZE, "H+ACT must fit");
constexpr size_t WS_ZX = WS_RA + AL(RA_SIZE);
constexpr size_t ZX_SIZE = (size_t)T_TOK * DM * 4;
constexpr size_t ZX_OALL = 0, ZX_OAP = (size_t)T_TOK * OA_LD * 2, ZX_OBT = ZX_OAP + (size_t)3 * T_TOK * 256 * 4;
static_assert(ZX_OBT + (size_t)T_TOK * 512 * 4 <= ZX_SIZE, "attention temporaries must fit");
constexpr size_t WS_XB = WS_ZX + ZX_SIZE;
constexpr size_t WS_S = WS_XB + (size_t)T_TOK * KLD * 2;
constexpr size_t WS_CUM = WS_S + (size_t)T_TOK * 32 * 4;
constexpr size_t WS_LSE = WS_CUM + (size_t)NBATCH * 6 * SEQ * 4;
constexpr size_t WS_KC = WS_LSE + (size_t)3 * T_TOK * 2 * 4;
constexpr size_t WS_B1P = WS_KC + (size_t)2 * NBATCH * 128 * 128 * 2;
constexpr size_t WS_BLB = WS_B1P + 1024;
constexpr size_t WS_BLA = WS_BLB + 4 * 2052 * 4;
constexpr size_t WS_CTR = AL(WS_BLA + 6 * 132 * 4);
constexpr size_t WS_BAR = WS_CTR + 1024;
constexpr size_t WS_TOTAL = WS_BAR + 16384;

struct Params {
    const float* x; const float* rel_bias; const float* w_in; const float* b_f; const float* b_nsa_gate; const float* cmp_pe;
    const float* cmp_w1; const float* cmp_b1; const float* cmp_w2; const float* cmp_b2; const float* w_gate; const float* b_gate;
    const float* w_pa; const float* w_pb; const float* w_pc; const float* w_out; const float* ln1_g; const float* ln1_b;
    const float* w_up; const float* conv_w; const float* conv_b; const float* w_down; const float* ln2_g; const float* ln2_b;
    float* out; char* ws;
    int never; int pad;
};

__device__ __forceinline__ unsigned cvt_pk_bf16(float lo, float hi) { unsigned r; asm volatile("s_nop 1\n\tv_cvt_pk_bf16_f32 %0, %1, %2" : "=v"(r) : "v"(lo), "v"(hi)); return r; }
__device__ __forceinline__ bf16_t f2bf(float f) { return (bf16_t)(cvt_pk_bf16(f, 0.f) & 0xffffu); }
__device__ __forceinline__ float bf2f(bf16_t b) { return __uint_as_float(((unsigned)b) << 16); }
__device__ __forceinline__ float bflo(unsigned w) { return __uint_as_float(w << 16); }
__device__ __forceinline__ float bfhi(unsigned w) { return __uint_as_float(w & 0xffff0000u); }
__device__ __forceinline__ float sigmoidf_(float z) { return __builtin_amdgcn_rcpf(1.0f + __expf(-z)); }
__device__ __forceinline__ float gelu_erf(float v) { return 0.5f * v * (1.0f + erff(v * 0.70710678118654752f)); }
__device__ __forceinline__ float gelu_as(float v) {
    const float av = fabsf(v), t = __builtin_amdgcn_rcpf(av * 0.2316418882f + 1.0f);
    float q = t * 0.5307027145f + (-0.7265760135f); q = q * t + 0.7107068705f; q = q * t + (-0.142248368f); q = q * t + 0.127414796f; q = q * t;
    const float e = __builtin_amdgcn_exp2f((v * v) * (-0.72134752044f));
    const float m = v * (q * e);
    return v < 0.f ? m : v - m;
}
__device__ __forceinline__ int otid() { int t = threadIdx.x; asm volatile("" : "+v"(t)); return t; }
template <class T> __device__ __forceinline__ T* lp(T* q) { return q; }
__device__ __forceinline__ int li(int v) { return v; }
template <class T> __device__ __forceinline__ T* lv(T* q) { asm volatile("" : "+v"(q)); return q; }

#define XB_TMO      128
#define XB_XCNT(j)  (256  + 64 * (j))
#define XB_XSUB(j)  (1280 + 64 * (j))
#define XB_XGEN(j)  (2304 + 64 * (j))
#define XB_TOP      3328
#define XB_TOPGEN   3392
#define XCD_BAR_WORDS 3456
#define XB_SPIN_CAP (1u << 18)
__device__ __forceinline__ unsigned xb_ld(unsigned* p)              { return __hip_atomic_load(p, __ATOMIC_RELAXED, __HIP_MEMORY_SCOPE_AGENT); }
__device__ __forceinline__ unsigned xb_add(unsigned* p, unsigned v) { return __hip_atomic_fetch_add(p, v, __ATOMIC_RELAXED, __HIP_MEMORY_SCOPE_AGENT); }
__device__ __forceinline__ unsigned xb_xcc_id() { return (unsigned)__builtin_amdgcn_s_getreg((3 << 11) | 20) & 0xFu; }
#define XB_SPIN(cond, bar) do { unsigned _sp = 0; while (cond) { __builtin_amdgcn_s_sleep(1); \
    if ((++_sp & 255u) == 0u) { if (xb_ld(&(bar)[XB_TMO])) break; if (_sp > XB_SPIN_CAP) { atomicAdd(&(bar)[XB_TMO], 1u); break; } } } } while (0)
struct XcdBarrier { unsigned* bar; unsigned x; volatile LAS unsigned* st; };
__device__ __forceinline__ XcdBarrier xcd_barrier_post(unsigned* bar, volatile LAS unsigned* st) {
    XcdBarrier b; b.bar = bar; b.x = xb_xcc_id(); b.st = st;
    if (threadIdx.x == 0) (void)xb_add(&bar[XB_XCNT(b.x)], 1u);
    return b;
}
__device__ __forceinline__ void xcd_barrier_complete(unsigned* bar, unsigned x, unsigned& nloc, unsigned& nx) {
    const unsigned G = gridDim.x * gridDim.y * gridDim.z;
    unsigned sum, cnt, mine, sp = 0u;
    for (;;) {
        sum = 0u; cnt = 0u; mine = 0u;
#pragma unroll
        for (unsigned j = 0; j < 16; ++j) { const unsigned c = xb_ld(&bar[XB_XCNT(j)]); sum += c; cnt += (c > 0u) ? 1u : 0u; mine = (j == x) ? c : mine; }
        if (sum == G) break;
        __builtin_amdgcn_s_sleep(1);
        if ((++sp & 255u) == 0u) { if (xb_ld(&bar[XB_TMO])) break; if (sp > XB_SPIN_CAP) { atomicAdd(&bar[XB_TMO], 1u); break; } }
    }
    nloc = mine > 0u ? mine : 1u; nx = cnt > 0u ? cnt : 1u;
}
__device__ __forceinline__ void xcd_barrier(const XcdBarrier& b) {
    asm volatile("s_waitcnt vmcnt(0)" ::: "memory");
    __syncthreads();
    if (threadIdx.x == 0) {
        unsigned* bar = b.bar;
        __builtin_amdgcn_s_waitcnt(0);
        unsigned nloc = b.st[0], nx = b.st[1];
        if (nloc == 0u) { xcd_barrier_complete(bar, b.x, nloc, nx); b.st[0] = nloc; b.st[1] = nx; }
        const unsigned old = xb_add(&bar[XB_XSUB(b.x)], 1u);
        const unsigned gen = old / nloc;
        if (old + 1u == (gen + 1u) * nloc) {
            __builtin_amdgcn_fence(__ATOMIC_RELEASE, "agent");
            asm volatile("s_waitcnt vmcnt(0)" ::: "memory");
            const unsigned og = xb_add(&bar[XB_TOP], 1u);
            const unsigned tg = og / nx;
            if (og + 1u == (tg + 1u) * nx) xb_add(&bar[XB_TOPGEN], 1u);
            else XB_SPIN(xb_ld(&bar[XB_TOPGEN]) == tg, bar);
            __builtin_amdgcn_fence(__ATOMIC_ACQUIRE, "agent");
            xb_add(&bar[XB_XGEN(b.x)], 1u);
            asm volatile("s_waitcnt vmcnt(0)" ::: "memory");
        } else {
            XB_SPIN(xb_ld(&bar[XB_XGEN(b.x)]) == gen, bar);
            __builtin_amdgcn_fence(__ATOMIC_ACQUIRE, "agent");
            asm volatile("s_waitcnt vmcnt(0)" ::: "memory");
        }
    }
    __syncthreads();
}
namespace pg8 {
constexpr int BM = 256, BK = 64, HALF = 128, HTB = HALF * BK * 2, STAGE_BYTES = 8 * HTB, NXCD = 8, WGM = 4;
__host__ __device__ __forceinline__ int lds_byte(int r, int c) { const int st = (r >> 4) * 2 + (c >> 5), rr = r & 15, cc = c & 31, ob = rr * 64 + cc * 2; return st * 1024 + (ob ^ (((ob >> 9) & 1) << 5)); }
__host__ __device__ __forceinline__ void stage_rc(int b, int& R, int& C) { const int st = b / 1024, sb = b % 1024, swz = sb ^ (((sb >> 9) & 1) << 5); R = (st >> 1) * 16 + swz / 64; C = (st & 1) * 32 + (swz % 64) / 2; }
__host__ __device__ __forceinline__ int perm32(int rho) { const int n = rho >> 4, i = rho & 15; return 8 * (i >> 2) + 4 * n + (i & 3); }
struct Unit { int pm, pn, seg; };
struct Gemm { const bf16_t* A; const bf16_t* Bt; int M, N, K, lda, ldb; };
struct StaticOrder {
    int nM, nN, nwg, G, c;
    __device__ void init(int M, int N, int G_, int c_, int nseg_) { nM = M / BM; nN = N / BM; nwg = nM * nN; G = G_; c = c_; nseg = nseg_; }
    int nseg;
    __device__ bool next(int ii, Unit& u) const {
        const int i = nseg == 1 ? ii : ii / 3; u.seg = nseg == 1 ? 0 : ii - 3 * i;
        const long L = (long)i * G + c; if (L >= nwg) return false;
        int wgid = (int)L; { const int q = nwg / NXCD, r = nwg % NXCD, xcd = wgid % NXCD, off = wgid / NXCD; wgid = (xcd < r ? xcd * (q + 1) : r * (q + 1) + (xcd - r) * q) + off; }
        const int nig = WGM * nN, gid = wgid / nig, fm = gid * WGM, gsz = (nM - fm) < WGM ? (nM - fm) : WGM;
        u.pm = fm + ((wgid % nig) % gsz); u.pn = (wgid % nig) / gsz; return true;
    }
};
template <class Epi>
__device__ __forceinline__ void gemm_phase(LAS unsigned char* lds, const Gemm g, const StaticOrder& S, const Epi& E, unsigned* lockstep) {
    const int tid = otid(), wid = __builtin_amdgcn_readfirstlane(tid >> 6), lane = tid & 63, wr = wid >> 2, wc = wid & 3, fr = lane & 15, fq = lane >> 4;
    unsigned voffA[2], voffB[2];
#pragma unroll
    for (int i = 0; i < 2; ++i) { int R, C; stage_rc(tid * 16 + i * 8192, R, C); const int Rb = Epi::PERM ? ((R & ~31) + perm32(R & 31)) : R;
        voffA[i] = (unsigned)(R * g.lda + C) * 2u; voffB[i] = (unsigned)(Rb * g.ldb + C) * 2u; }
    const size_t kstep = (size_t)(BK * 2);
    const size_t hstepA = (size_t)HALF * g.lda * 2, hstepB = (size_t)HALF * g.ldb * 2;
    const size_t tstepA = 2 * hstepA, tstepB = 2 * hstepB;
    const unsigned ldsw = (unsigned)wid * 1024u;
    const int aoff = lds_byte(wr * 64 + fr, fq * 8), boff = lds_byte(wc * 32 + fr, fq * 8);
#define PG8_SA(b, h) (((b) * 2 + (h)) * HTB)
#define PG8_SB(b, h) ((4 + (b) * 2 + (h)) * HTB)
#define PG8_STAGE(bufoff, gbase, voff) do { _Pragma("unroll") for (int _i = 0; _i < 2; ++_i) \
        __builtin_amdgcn_global_load_lds((const unsigned*)((const char*)(gbase) + (voff)[_i]), (LAS unsigned*)(lds + (bufoff) + ldsw + _i * 8192), 16, 0, 0); } while (0)
#define PG8_LDA(dst, b, h) do { _Pragma("unroll") for (int m = 0; m < 4; ++m) _Pragma("unroll") for (int k = 0; k < 2; ++k) dst[m][k] = *(const LAS bf16x8*)(lds + PG8_SA(b, h) + aoff + m * 2048 + k * 1024); } while (0)
#define PG8_LDB(dst, b, h) do { _Pragma("unroll") for (int n = 0; n < 2; ++n) _Pragma("unroll") for (int k = 0; k < 2; ++k) dst[n][k] = *(const LAS bf16x8*)(lds + PG8_SB(b, h) + boff + n * 2048 + k * 1024); } while (0)
#define PG8_MMA(ai, bj, At, Bt) do { __builtin_amdgcn_s_setprio(1); _Pragma("unroll") for (int m = 0; m < 4; ++m) _Pragma("unroll") for (int n = 0; n < 2; ++n) _Pragma("unroll") for (int k = 0; k < 2; ++k) \
        acc[ai][bj][m][n] = __builtin_amdgcn_mfma_f32_16x16x32_bf16(Bt[n][k], At[m][k], acc[ai][bj][m][n], 0, 0, 0); __builtin_amdgcn_s_setprio(0); } while (0)
#define PG8_WAIT_V(n) asm volatile("s_waitcnt vmcnt(" #n ")" ::: "memory")
#define PG8_WAIT_L(n) asm volatile("s_waitcnt lgkmcnt(" #n ")" ::: "memory")
#define PG8_BAR __builtin_amdgcn_s_barrier()
#define PG8_SCHED __builtin_amdgcn_sched_barrier(0)
    Unit cur, nxt; int ui = 0;
    if (!S.next(0, cur)) return;
    f32x4 acc[2][2][4][2];
#pragma unroll
    for (int a = 0; a < 2; ++a)
#pragma unroll
        for (int b = 0; b < 2; ++b)
#pragma unroll
            for (int m = 0; m < 4; ++m)
#pragma unroll
                for (int n = 0; n < 2; ++n) acc[a][b][m][n] = (f32x4){0.f, 0.f, 0.f, 0.f};
    bf16x8 At[4][2], B0[2][2], B1[2][2];
#define PG8_KOFF(u) (Epi::NSEG == 1 ? 0 : ((u).seg == 0 ? 0 : ((u).seg == 1 ? 256 : 768)))
#define PG8_NT(u) (Epi::NSEG == 1 ? g.K / BK : ((u).seg == 0 ? 4 : ((u).seg == 1 ? 8 : 12)))
    const char* cA = (const char*)g.A + (size_t)(Epi::AFIX ? (cur.pm & 7) : cur.pm) * tstepA + PG8_KOFF(cur) * 2; const char* cB = (const char*)g.Bt + (size_t)(Epi::BFIX ? (cur.pn & 3) : cur.pn) * tstepB + PG8_KOFF(cur) * 2;
    int nt = PG8_NT(cur);
    PG8_STAGE(PG8_SB(0, 0), cB, voffB); PG8_STAGE(PG8_SA(0, 0), cA, voffA); PG8_STAGE(PG8_SB(0, 1), cB + hstepB, voffB); PG8_STAGE(PG8_SA(0, 1), cA + hstepA, voffA);
    if (wr == 1) PG8_BAR;
    PG8_WAIT_V(4); PG8_BAR;
    PG8_STAGE(PG8_SB(1, 0), cB + kstep, voffB); PG8_STAGE(PG8_SA(1, 0), cA + kstep, voffA); PG8_STAGE(PG8_SB(1, 1), cB + hstepB + kstep, voffB);
    PG8_WAIT_V(6); PG8_BAR;
    for (;;) {
        const bool has_next = S.next(ui + 1, nxt);
        const char* nA = has_next ? (const char*)g.A + (size_t)(Epi::AFIX ? (nxt.pm & 7) : nxt.pm) * tstepA + PG8_KOFF(nxt) * 2 : cA; const char* nB = has_next ? (const char*)g.Bt + (size_t)(Epi::BFIX ? (nxt.pn & 3) : nxt.pn) * tstepB + PG8_KOFF(nxt) * 2 : cB;
        for (int t = 0; t < nt; t += 2) {
            const bool last = (t == nt - 2);
            const char* a1 = cA + (size_t)(t + 1) * kstep;
            const char* a2 = last ? nA : cA + (size_t)(t + 2) * kstep; const char* b2 = last ? nB : cB + (size_t)(t + 2) * kstep;
            const char* a3 = a2 + kstep; const char* b3 = b2 + kstep;
            PG8_LDB(B0, 0, 0); PG8_SCHED; PG8_LDA(At, 0, 0); PG8_STAGE(PG8_SA(1, 1), a1 + hstepA, voffA);
            PG8_WAIT_L(8); PG8_BAR; PG8_WAIT_L(0); PG8_MMA(0, 0, At, B0); PG8_BAR; PG8_SCHED;
            PG8_LDB(B1, 0, 1); PG8_STAGE(PG8_SB(0, 0), b2, voffB);
            PG8_BAR; PG8_WAIT_L(0); PG8_MMA(0, 1, At, B1); PG8_BAR;
            PG8_LDA(At, 0, 1); PG8_STAGE(PG8_SA(0, 0), a2, voffA);
            PG8_BAR; PG8_WAIT_L(0); PG8_MMA(1, 0, At, B0); PG8_BAR; PG8_SCHED;
            PG8_STAGE(PG8_SB(0, 1), b2 + hstepB, voffB);
            PG8_WAIT_V(6); PG8_BAR; PG8_MMA(1, 1, At, B1); PG8_BAR;
            PG8_LDB(B0, 1, 0); PG8_SCHED; PG8_LDA(At, 1, 0); PG8_STAGE(PG8_SA(0, 1), a2 + hstepA, voffA);
            PG8_WAIT_L(8); PG8_BAR; PG8_WAIT_L(0); PG8_MMA(0, 0, At, B0); PG8_BAR; PG8_SCHED;
            PG8_LDB(B1, 1, 1); PG8_STAGE(PG8_SB(1, 0), b3, voffB);
            PG8_BAR; PG8_WAIT_L(0); PG8_MMA(0, 1, At, B1); PG8_BAR;
            PG8_LDA(At, 1, 1); PG8_STAGE(PG8_SA(1, 0), a3, voffA);
            PG8_BAR; PG8_WAIT_L(0); PG8_MMA(1, 0, At, B0); PG8_BAR; PG8_SCHED;
            PG8_STAGE(PG8_SB(1, 1), b3 + hstepB, voffB);
            PG8_WAIT_V(6); PG8_BAR; PG8_MMA(1, 1, At, B1); PG8_BAR;
        }
        E(acc, cur, wr, wc, fr, fq);
        if (!has_next) break;
        if (lockstep) {
            if (tid == 0) { __hip_atomic_fetch_add(lockstep, 1u, __ATOMIC_RELAXED, __HIP_MEMORY_SCOPE_AGENT);
                const unsigned want = (unsigned)(ui + 1) * gridDim.x; unsigned sp = 0;
                while (__hip_atomic_load(lockstep, __ATOMIC_RELAXED, __HIP_MEMORY_SCOPE_AGENT) < want && ++sp < (1u << 16)) __builtin_amdgcn_s_sleep(1); }
            PG8_BAR;
        }
#pragma unroll
        for (int a = 0; a < 2; ++a)
#pragma unroll
            for (int b = 0; b < 2; ++b)
#pragma unroll
                for (int m = 0; m < 4; ++m)
#pragma unroll
                    for (int n = 0; n < 2; ++n) acc[a][b][m][n] = (f32x4){0.f, 0.f, 0.f, 0.f};
        cur = nxt; cA = nA; cB = nB; ++ui; nt = PG8_NT(cur);
    }
    PG8_WAIT_V(0);
    if (wr == 0) PG8_BAR;
    PG8_BAR;
#undef PG8_SA
#undef PG8_KOFF
#undef PG8_NT
#undef PG8_SB
#undef PG8_STAGE
#undef PG8_LDA
#undef PG8_LDB
#undef PG8_MMA
#undef PG8_WAIT_V
#undef PG8_WAIT_L
#undef PG8_BAR
#undef PG8_SCHED
}

struct Epi1 {
    static constexpr bool PERM = true, AFIX = false, BFIX = false; static constexpr int NSEG = 1;
    bf16_t* U; bf16_t* G; float* S; const float* b_gate;
    __device__ __forceinline__ void operator()(const f32x4 (&acc)[2][2][4][2], const Unit& u, int wr, int wc, int fr, int fq) const {
        const int row0 = u.pm * BM + wr * 64 + fr;
        if (u.pn < 23) {
            const int col0 = u.pn * BM + wc * 32 + 8 * fq;
#pragma unroll
            for (int ai = 0; ai < 2; ++ai)
#pragma unroll
                for (int m = 0; m < 4; ++m) { bf16_t* rowp = U + (size_t)(row0 + ai * HALF + m * 16) * U_LD + col0;
#pragma unroll
                    for (int bj = 0; bj < 2; ++bj) { const f32x4 v0 = acc[ai][bj][m][0], v1 = acc[ai][bj][m][1];
                        u32x4 w; w.x = cvt_pk_bf16(v0[0], v0[1]); w.y = cvt_pk_bf16(v0[2], v0[3]); w.z = cvt_pk_bf16(v1[0], v1[1]); w.w = cvt_pk_bf16(v1[2], v1[3]);
                        *(u32x4*)(rowp + bj * HALF) = w; } }
        } else if (u.pn < 47) {
            const int col0 = (u.pn - 23) * BM + wc * 32 + 8 * fq;
            f32x4 bv[2][2];
#pragma unroll
            for (int bj = 0; bj < 2; ++bj)
#pragma unroll
                for (int n = 0; n < 2; ++n) bv[bj][n] = *(const f32x4*)(b_gate + col0 + bj * HALF + 4 * n);
#pragma unroll
            for (int ai = 0; ai < 2; ++ai)
#pragma unroll
                for (int m = 0; m < 4; ++m) { bf16_t* rowp = G + (size_t)(row0 + ai * HALF + m * 16) * G_LD + col0;
#pragma unroll
                    for (int bj = 0; bj < 2; ++bj) { f32x4 v0 = acc[ai][bj][m][0] + bv[bj][0], v1 = acc[ai][bj][m][1] + bv[bj][1];
#pragma unroll
                        for (int j = 0; j < 4; ++j) { v0[j] = sigmoidf_(v0[j]); v1[j] = sigmoidf_(v1[j]); }
                        u32x4 w; w.x = cvt_pk_bf16(v0[0], v0[1]); w.y = cvt_pk_bf16(v0[2], v0[3]); w.z = cvt_pk_bf16(v1[0], v1[1]); w.w = cvt_pk_bf16(v1[2], v1[3]);
                        *(u32x4*)(rowp + bj * HALF) = w; } }
        } else {
            if (wc == 0) {
#pragma unroll
                for (int ai = 0; ai < 2; ++ai)
#pragma unroll
                    for (int m = 0; m < 4; ++m) { float* rowp = S + (size_t)(row0 + ai * HALF + m * 16) * 32 + 8 * fq;
                        *(f32x4*)(rowp) = acc[ai][0][m][0]; *(f32x4*)(rowp + 4) = acc[ai][0][m][1]; }
            }
        }
    }
};
struct Epi2 {
    static constexpr bool PERM = true, AFIX = false, BFIX = false; static constexpr int NSEG = 3;
    const bf16_t* G; bf16_t* O; bf16_t* T;
    __device__ __forceinline__ void operator()(const f32x4 (&acc)[2][2][4][2], const Unit& u, int wr, int wc, int fr, int fq) const {
        const int row0 = u.pm * BM + wr * 64 + fr, col0 = u.pn * BM + wc * 32 + 8 * fq, seg = u.seg;
        u32x4 ga[2], ta[2];
        { const size_t row = (size_t)row0;
          ga[0] = *(const u32x4*)(G + row * G_LD + seg * 2048 + col0); ga[1] = *(const u32x4*)(G + row * G_LD + seg * 2048 + col0 + HALF);
          if (seg > 0) { ta[0] = *(const u32x4*)(T + row * DM + col0); ta[1] = *(const u32x4*)(T + row * DM + col0 + HALF); } else { ta[0] = (u32x4){0u, 0u, 0u, 0u}; ta[1] = ta[0]; } }
#pragma unroll
        for (int g = 0; g < 8; ++g) { const int ai = g >> 2, m = g & 3; const size_t row = (size_t)(row0 + ai * HALF + m * 16);
            u32x4 gn[2] = {ga[0], ga[1]}, tn[2] = {ta[0], ta[1]};
            if (g < 7) { const size_t rown = (size_t)(row0 + ((g + 1) >> 2) * HALF + ((g + 1) & 3) * 16);
                gn[0] = *(const u32x4*)(G + rown * G_LD + seg * 2048 + col0); gn[1] = *(const u32x4*)(G + rown * G_LD + seg * 2048 + col0 + HALF);
                if (seg > 0) { tn[0] = *(const u32x4*)(T + rown * DM + col0); tn[1] = *(const u32x4*)(T + rown * DM + col0 + HALF); } }
            bf16_t* tp = (seg < 2 ? T + row * DM : O + row * KLD) + col0;
#pragma unroll
            for (int bj = 0; bj < 2; ++bj) {
                const u32x4 a = ga[bj];
                const f32x4 g0 = {bflo(a.x), bfhi(a.x), bflo(a.y), bfhi(a.y)}, g1 = {bflo(a.z), bfhi(a.z), bflo(a.w), bfhi(a.w)};
                f32x4 v0 = acc[ai][bj][m][0] * g0, v1 = acc[ai][bj][m][1] * g1;
                if (seg > 0) { const u32x4 t = ta[bj];
                    v0 += (f32x4){bflo(t.x), bfhi(t.x), bflo(t.y), bfhi(t.y)}; v1 += (f32x4){bflo(t.z), bfhi(t.z), bflo(t.w), bfhi(t.w)}; }
                u32x4 w; w.x = cvt_pk_bf16(v0[0], v0[1]); w.y = cvt_pk_bf16(v0[2], v0[3]); w.z = cvt_pk_bf16(v1[0], v1[1]); w.w = cvt_pk_bf16(v1[2], v1[3]);
                *(u32x4*)(tp + bj * HALF) = w; }
            ga[0] = gn[0]; ga[1] = gn[1]; ta[0] = tn[0]; ta[1] = tn[1];
            asm volatile("" ::: "memory"); }
    }
};
struct EpiRes {
    static constexpr bool PERM = false, AFIX = false, BFIX = false; static constexpr int NSEG = 1;
    const float* R; float* Z;
    __device__ __forceinline__ void operator()(const f32x4 (&acc)[2][2][4][2], const Unit& u, int wr, int wc, int fr, int fq) const {
        const int row0 = u.pm * BM + wr * 64 + fr, col0 = u.pn * BM + wc * 32 + 4 * fq;
#pragma unroll
        for (int ai = 0; ai < 2; ++ai) {
            f32x4 r[4][2][2];
#pragma unroll
            for (int m = 0; m < 4; ++m) { const size_t off = (size_t)(row0 + ai * HALF + m * 16) * DM + col0;
#pragma unroll
                for (int bj = 0; bj < 2; ++bj)
#pragma unroll
                    for (int n = 0; n < 2; ++n) r[m][bj][n] = *(const f32x4*)(R + off + bj * HALF + n * 16); }
            asm volatile("" ::: "memory");
#pragma unroll
            for (int m = 0; m < 4; ++m) { const size_t off = (size_t)(row0 + ai * HALF + m * 16) * DM + col0;
#pragma unroll
                for (int bj = 0; bj < 2; ++bj)
#pragma unroll
                    for (int n = 0; n < 2; ++n) *(f32x4*)(Z + off + bj * HALF + n * 16) = r[m][bj][n] * ALPHA + acc[ai][bj][m][n]; }
            asm volatile("" ::: "memory");
        }
    }
};
struct EpiH {
    static constexpr bool PERM = true, AFIX = false, BFIX = false; static constexpr int NSEG = 1;
    bf16_t* H; int ldh;
    __device__ __forceinline__ void operator()(const f32x4 (&acc)[2][2][4][2], const Unit& u, int wr, int wc, int fr, int fq) const {
        const int row0 = u.pm * BM + wr * 64 + fr, col0 = u.pn * BM + wc * 32 + 8 * fq;
#pragma unroll
        for (int ai = 0; ai < 2; ++ai)
#pragma unroll
            for (int m = 0; m < 4; ++m) { bf16_t* rowp = H + (size_t)(row0 + ai * HALF + m * 16) * ldh + col0;
#pragma unroll
                for (int bj = 0; bj < 2; ++bj) { const f32x4 v0 = acc[ai][bj][m][0], v1 = acc[ai][bj][m][1];
                    u32x4 w; w.x = cvt_pk_bf16(v0[0], v0[1]); w.y = cvt_pk_bf16(v0[2], v0[3]); w.z = cvt_pk_bf16(v1[0], v1[1]); w.w = cvt_pk_bf16(v1[2], v1[3]);
                    *(u32x4*)(rowp + bj * HALF) = w; } }
    }
};
}
struct Seg { const float* src; bf16_t* dst; int ld_src, K, col0, width, ld_dst, row0, rows, tile0; };
__device__ __forceinline__ void add_seg(Seg* segs, int& n, int& tiles, const float* src, bf16_t* dst, int ld_src, int K, int col0, int width, int ld_dst, int row0, int rows) {
    Seg s; s.src = src; s.dst = dst; s.ld_src = ld_src; s.K = K; s.col0 = col0; s.width = width; s.ld_dst = ld_dst; s.row0 = row0; s.rows = rows; s.tile0 = tiles;
    segs[n] = s; ++n; tiles += ((rows + 127) / 128) * (K / 128);
    asm volatile("" ::: "memory");
}
__device__ __forceinline__ void convert_tiles(const Params& p, int layer, int group, LAS unsigned char* lds, int t_begin, int t_end, int t_step) {
    char* const wsl = lp(p.ws);
    Seg* segs = (Seg*)(unsigned char*)lds; LAS int* meta = (LAS int*)(lds + 3072); LAS float* tile = (LAS float*)(lds + 4096);
    char* W = wsl + WS_W;
    __syncthreads();
    if (threadIdx.x == 0) {
        int n = 0, tiles = 0;
        if (group == 1) {
            const float* win = p.w_in + (size_t)layer * 2048 * NIN; bf16_t* bt1 = (bf16_t*)(W + W1_BT1);
            add_seg(segs, n, tiles, win, bt1, NIN, 2048, 0, 2816, KLD, 0, 2816);
            add_seg(segs, n, tiles, win, bt1, NIN, 2048, 3596, 2304, KLD, 2816, 2304);
            add_seg(segs, n, tiles, win, bt1, NIN, 2048, 3072, 512, KLD, 5120, 512);
            add_seg(segs, n, tiles, win, bt1, NIN, 2048, 2816, 256, KLD, 5632, 256);
            add_seg(segs, n, tiles, p.w_gate + (size_t)layer * 2048 * 6144, bt1, 6144, 2048, 0, 6144, KLD, 5888, 6144);
            add_seg(segs, n, tiles, win, bt1, NIN, 2048, 3584, 12, KLD, 12032, 12);
            add_seg(segs, n, tiles, win, bt1, NIN, 2048, 5900, 6, KLD, 12044, 6);
            add_seg(segs, n, tiles, win, bt1, NIN, 2048, 0, 0, KLD, 12050, 238);
            bf16_t* btp = (bf16_t*)(W + W1_BTP);
            add_seg(segs, n, tiles, p.w_pa + (size_t)layer * 256 * 2048, btp, 2048, 256, 0, 2048, 1536, 0, 2048);
            add_seg(segs, n, tiles, p.w_pb + (size_t)layer * 512 * 2048, btp + 256, 2048, 512, 0, 2048, 1536, 0, 2048);
            add_seg(segs, n, tiles, p.w_pc + (size_t)layer * 768 * 2048, btp + 768, 2048, 768, 0, 2048, 1536, 0, 2048);
            add_seg(segs, n, tiles, p.w_out + (size_t)layer * 2048 * 2048, (bf16_t*)(W + W1_BTOUT), 2048, 2048, 0, 2048, KLD, 0, 2048);
            for (int c = 0; c < 2; ++c) {
                add_seg(segs, n, tiles, p.cmp_w1 + ((size_t)layer * 2 + c) * 4096 * 128, (bf16_t*)(W + W1_W1T) + (size_t)c * 128 * 4096, 128, 4096, 0, 128, 4096, 0, 128);
                add_seg(segs, n, tiles, p.cmp_w2 + ((size_t)layer * 2 + c) * 128 * 128, (bf16_t*)(W + W1_W2T) + (size_t)c * 128 * 128, 128, 128, 0, 128, 128, 0, 128);
            }
        } else {
            const float* wup = p.w_up + (size_t)layer * 2048 * 11264; bf16_t* btu = (bf16_t*)(W + W2_BTUP);
            add_seg(segs, n, tiles, wup, btu, 11264, 2048, 0, FFA, KLD, 0, FFA);
            add_seg(segs, n, tiles, wup, btu, 11264, 2048, DFF, FFA, KLD, FFA, FFA);
            add_seg(segs, n, tiles, wup, btu, 11264, 2048, FFA, FFB, KLD, 2 * FFA, FFB);
            add_seg(segs, n, tiles, wup, btu, 11264, 2048, DFF + FFA, FFB, KLD, 2 * FFA + FFB, FFB);
            add_seg(segs, n, tiles, p.w_down + (size_t)layer * DFF * 2048, (bf16_t*)(W + W2_BTDN), 2048, DFF, 0, 2048, DFF, 0, 2048);
        }
        meta[0] = n; meta[1] = tiles;
    }
    __syncthreads();
    const int nseg = meta[0], total = meta[1];
    const int tid = otid();
    float r[32]; Seg sg; int n0 = 0, k0 = 0;
    auto locate = [&](int t) { int s = 0; while (s + 1 < nseg && segs[s + 1].tile0 <= t) ++s; sg = segs[s];
        const int local = t - sg.tile0, nk = sg.K / 128, rt = local / nk, kt = local - rt * nk; n0 = rt * 128; k0 = kt * 128; };
    auto issue = [&]() { const int n = tid & 127, kk0 = tid >> 7; const bool ok = (n0 + n) < sg.width;
        const float* sp = sg.src + (size_t)(k0 + kk0) * sg.ld_src + sg.col0 + n0 + n;
#pragma unroll
        for (int i = 0; i < 32; ++i) r[i] = ok ? sp[(size_t)(4 * i) * sg.ld_src] : 0.f; };
    const int tend = t_end < total ? t_end : total;
    int t = t_begin;
    if (t < tend) { locate(t); issue(); }
    while (t < tend) {
        { const int n = tid & 127, kk0 = tid >> 7;
#pragma unroll
          for (int i = 0; i < 32; ++i) tile[(kk0 + 4 * i) * 129 + n] = r[i]; }
        __syncthreads();
        const Seg cs = sg; const int cn0 = n0, ck0 = k0;
        const int tn = t + t_step;
        if (tn < tend) { locate(tn); issue(); }
        { const int kp = (tid & 63) * 2, nn0 = tid >> 6;
#pragma unroll
          for (int j = 0; j < 16; ++j) { const int n = nn0 + 8 * j;
              if (cn0 + n < cs.rows) *(unsigned*)(cs.dst + (size_t)(cs.row0 + cn0 + n) * cs.ld_dst + ck0 + kp) = cvt_pk_bf16(tile[kp * 129 + n], tile[(kp + 1) * 129 + n]); } }
        __syncthreads();
        t = tn;
    }
}
__device__ __forceinline__ void convert_phase(const Params& p, int layer, int group, LAS unsigned char* lds) { convert_tiles(p, layer, group, lds, blockIdx.x, 1 << 30, gridDim.x); }
constexpr int CV2_TILES = (11264 / 128) * (2048 / 128) + (2048 / 128) * (DFF / 128), CV2_CHUNK = 32, CV2_ITEMS = (CV2_TILES + CV2_CHUNK - 1) / CV2_CHUNK;
__device__ __forceinline__ void b1p_phase(const Params& p, int layer) {
    char* const wsl = lp(p.ws);
    const int tid_ = otid(), lane = tid_ & 63, wid = tid_ >> 6;
    float* b1p = (float*)(wsl + WS_B1P);
    for (int o = blockIdx.x + gridDim.x * wid; o < 256; o += gridDim.x * 8) { const int c = o >> 7, e = o & 127;
        const float* pe = p.cmp_pe + ((size_t)layer * 2 + c) * 4096 + lane; const float* w1 = p.cmp_w1 + ((size_t)layer * 2 + c) * 4096 * 128 + (size_t)lane * 128 + e;
        float s = 0.f;
#pragma unroll 16
        for (int i = 0; i < 64; ++i) s += pe[i * 64] * w1[(size_t)i * 64 * 128];
#pragma unroll
        for (int off = 32; off >= 1; off >>= 1) s += __shfl_xor(s, off);
        if (lane == 0) b1p[o] = s + p.cmp_b1[(layer * 2 + c) * 128 + e]; }
}
__device__ __forceinline__ int t5_bucket_dev(int d) {
    if (d < 16) return d;
    const float lr = logf((float)d / 16.0f) / 4.852030263919617f; const int lg = 16 + (int)(lr * 16.0f); return lg < 31 ? lg : 31;
}
__device__ __forceinline__ void bucket_phase(const Params& p) {
    char* const wsl = lp(p.ws);
    float* blb = (float*)(wsl + WS_BLB); float* bla = (float*)(wsl + WS_BLA);
    for (int i = blockIdx.x * 512 + threadIdx.x; i < 4 * 2052 + 6 * 132; i += gridDim.x * 512) {
        if (i < 4 * 2052) { const int h = i / 2052, d = i - h * 2052; blb[i] = (d <= 2048) ? p.rel_bias[t5_bucket_dev(d) * 10 + 6 + h] * LOG2E : 0.f; }
        else { const int k = i - 4 * 2052, head = k / 132, j = k - head * 132, dil = head < 2 ? 1 : (head < 4 ? 4 : 16);
            bla[k] = (j <= 128) ? p.rel_bias[t5_bucket_dev(j * dil) * 10 + head] * LOG2E : 0.f; }
    }
}
__device__ __forceinline__ void xcvt_phase(const float* x, bf16_t* xb) {
    const size_t n8 = (size_t)T_TOK * DM / 8;
#pragma unroll 4
    for (size_t i = (size_t)blockIdx.x * 512 + threadIdx.x; i < n8; i += (size_t)gridDim.x * 512) {
        const f32x4 a = *(const f32x4*)(x + i * 8), b = *(const f32x4*)(x + i * 8 + 4);
        u32x4 w; w.x = cvt_pk_bf16(a[0], a[1]); w.y = cvt_pk_bf16(a[2], a[3]); w.z = cvt_pk_bf16(b[0], b[1]); w.w = cvt_pk_bf16(b[2], b[3]);
        const size_t row = i >> 8, c8 = i & 255;
        *(u32x4*)(xb + row * KLD + c8 * 8) = w; }
}
template <bool WB>
__device__ __forceinline__ void ln_phase(const float* src, float* dstf, bf16_t* dstb, const float* gam, const float* bet) {
    const int tid_ = otid(), lane = tid_ & 63, gw = blockIdx.x * 8 + (tid_ >> 6), nw = gridDim.x * 8;
    f32x4 gv[8], bv[8];
#pragma unroll
    for (int i = 0; i < 8; ++i) { gv[i] = *(const f32x4*)(gam + (i * 64 + lane) * 4); bv[i] = *(const f32x4*)(bet + (i * 64 + lane) * 4); }
    for (int row = gw; row < T_TOK; row += nw) {
        const float* sp = src + (size_t)row * DM; f32x4 v[8]; float s = 0.f;
#pragma unroll
        for (int i = 0; i < 8; ++i) { v[i] = *(const f32x4*)(sp + (i * 64 + lane) * 4); s += (v[i][0] + v[i][1]) + (v[i][2] + v[i][3]); }
#pragma unroll
        for (int off = 32; off >= 1; off >>= 1) s += __shfl_xor(s, off);
        const float mu = s * (1.0f / 2048.0f); float q = 0.f;
#pragma unroll
        for (int i = 0; i < 8; ++i) { const f32x4 d = v[i] - mu; q += (d[0] * d[0] + d[1] * d[1]) + (d[2] * d[2] + d[3] * d[3]); }
#pragma unroll
        for (int off = 32; off >= 1; off >>= 1) q += __shfl_xor(q, off);
        const float rstd = rsqrtf(q * (1.0f / 2048.0f) + LN_EPS);
#pragma unroll
        for (int i = 0; i < 8; ++i) { const int c = (i * 64 + lane) * 4; const f32x4 g = gv[i], b = bv[i];
            const f32x4 y = (v[i] - mu) * rstd * g + b;
            *(f32x4*)(dstf + (size_t)row * DM + c) = y;
            if (WB) { u32x2 w; w.x = cvt_pk_bf16(y[0], y[1]); w.y = cvt_pk_bf16(y[2], y[3]); *(u32x2*)(dstb + (size_t)row * KLD + c) = w; } }
    }
}
__device__ __forceinline__ void conv_phase(const bf16_t* H, int FF, int foff, const float* conv_w, const float* conv_b, bf16_t* ACT) {
    const int nch = FF / 8, ntask = (T_TOK / 16) * nch, ldh = 2 * FF;
    for (int task = blockIdx.x * 512 + otid(); task < ntask; task += gridDim.x * 512) {
        const int tg = task / nch, ch = task - tg * nch, t0 = tg * 16, c0 = ch * 8;
        float wa[3][8], wb[3][8], ba[8], bb[8];
#pragma unroll
        for (int j = 0; j < 3; ++j)
#pragma unroll
            for (int e = 0; e < 8; ++e) { wa[j][e] = conv_w[(size_t)j * 2 * DFF + foff + c0 + e]; wb[j][e] = conv_w[(size_t)j * 2 * DFF + DFF + foff + c0 + e]; }
#pragma unroll
        for (int e = 0; e < 8; ++e) { ba[e] = conv_b[foff + c0 + e]; bb[e] = conv_b[DFF + foff + c0 + e]; }
        float a1[8], a2[8], b1[8], b2[8];
        const bool first = (t0 % SEQ) == 0;
        { u32x4 za = {0, 0, 0, 0}, zb = za, ya = za, yb = za;
          if (!first) { za = *(const u32x4*)(H + (size_t)(t0 - 1) * ldh + c0); zb = *(const u32x4*)(H + (size_t)(t0 - 1) * ldh + FF + c0);
                        ya = *(const u32x4*)(H + (size_t)(t0 - 2) * ldh + c0); yb = *(const u32x4*)(H + (size_t)(t0 - 2) * ldh + FF + c0); }
          a1[0] = bflo(za.x); a1[1] = bfhi(za.x); a1[2] = bflo(za.y); a1[3] = bfhi(za.y); a1[4] = bflo(za.z); a1[5] = bfhi(za.z); a1[6] = bflo(za.w); a1[7] = bfhi(za.w);
          b1[0] = bflo(zb.x); b1[1] = bfhi(zb.x); b1[2] = bflo(zb.y); b1[3] = bfhi(zb.y); b1[4] = bflo(zb.z); b1[5] = bfhi(zb.z); b1[6] = bflo(zb.w); b1[7] = bfhi(zb.w);
          a2[0] = bflo(ya.x); a2[1] = bfhi(ya.x); a2[2] = bflo(ya.y); a2[3] = bfhi(ya.y); a2[4] = bflo(ya.z); a2[5] = bfhi(ya.z); a2[6] = bflo(ya.w); a2[7] = bfhi(ya.w);
          b2[0] = bflo(yb.x); b2[1] = bfhi(yb.x); b2[2] = bflo(yb.y); b2[3] = bfhi(yb.y); b2[4] = bflo(yb.z); b2[5] = bfhi(yb.z); b2[6] = bflo(yb.w); b2[7] = bfhi(yb.w); }
#pragma unroll 1
        for (int i0 = 0; i0 < 16; i0 += 4) {
            u32x4 xa4[4], xb4[4];
#pragma unroll
            for (int j = 0; j < 4; ++j) { xa4[j] = *(const u32x4*)(H + (size_t)(t0 + i0 + j) * ldh + c0); xb4[j] = *(const u32x4*)(H + (size_t)(t0 + i0 + j) * ldh + FF + c0); }
            asm volatile("" ::: "memory");
#pragma unroll
            for (int j = 0; j < 4; ++j) { const u32x4 xa = xa4[j], xb = xb4[j];
                float a0[8], b0[8];
                a0[0] = bflo(xa.x); a0[1] = bfhi(xa.x); a0[2] = bflo(xa.y); a0[3] = bfhi(xa.y); a0[4] = bflo(xa.z); a0[5] = bfhi(xa.z); a0[6] = bflo(xa.w); a0[7] = bfhi(xa.w);
                b0[0] = bflo(xb.x); b0[1] = bfhi(xb.x); b0[2] = bflo(xb.y); b0[3] = bfhi(xb.y); b0[4] = bflo(xb.z); b0[5] = bfhi(xb.z); b0[6] = bflo(xb.w); b0[7] = bfhi(xb.w);
                float r[8];
#pragma unroll
                for (int e = 0; e < 8; ++e) { const float ca = ba[e] + wa[0][e] * a2[e] + wa[1][e] * a1[e] + wa[2][e] * a0[e];
                    const float cb = bb[e] + wb[0][e] * b2[e] + wb[1][e] * b1[e] + wb[2][e] * b0[e];
                    r[e] = gelu_as(ca) * cb; a2[e] = a1[e]; a1[e] = a0[e]; b2[e] = b1[e]; b1[e] = b0[e]; }
                u32x4 w; w.x = cvt_pk_bf16(r[0], r[1]); w.y = cvt_pk_bf16(r[2], r[3]); w.z = cvt_pk_bf16(r[4], r[5]); w.w = cvt_pk_bf16(r[6], r[7]);
                *(u32x4*)(ACT + (size_t)(t0 + i0 + j) * DFF + foff + c0) = w; }
        }
    }
}
__device__ __forceinline__ float log_sigmoid_(float z) { return (z >= 0.f) ? -log1pf(__expf(-z)) : (z - log1pf(__expf(z))); }
__device__ __forceinline__ void cumsum_task(int bh, const float* S, const float* b_f, float* CUM, LAS unsigned char* lds) {
    const int tid = otid(), lane = tid & 63, wid = tid >> 6, b = bh / 6, h = bh - b * 6; const float bf = b_f[h];
    const float* sp = S + ((size_t)b * SEQ + lane * 32) * 32 + 12 + h;
    LAS float* zb = (LAS float*)lds + wid * 2048 + lane;
#pragma unroll
    for (int i = 0; i < 32; ++i) zb[i * 64] = sp[(size_t)i * 32];
    float tot = 0.f;
#pragma unroll 1
    for (int i = 0; i < 32; ++i) { const float ls = log_sigmoid_(zb[i * 64] + bf); zb[i * 64] = ls; tot += ls; }
    float inc = tot;
#pragma unroll
    for (int off = 1; off < 64; off <<= 1) { const float o = __shfl_up(inc, off); if (lane >= off) inc += o; }
    float run = inc - tot;
    float* cp = CUM + (size_t)bh * SEQ + lane * 32;
#pragma unroll 4
    for (int i = 0; i < 32; ++i) { run += zb[i * 64]; cp[i] = run; }
}
__device__ __forceinline__ void cmp_mlp_unit(int unit, const Params& p, int layer, LAS unsigned char* lds) {
    char* const wsl = lp(p.ws);
    const int tid = otid(), wid = tid >> 6, lane = tid & 63, row = lane & 15, k8 = lane >> 4;
    const int c = unit >> 6, b = (unit >> 3) & 7, ng = unit & 7;
    const bf16_t* U = (const bf16_t*)(wsl + WS_RA + RA_U);
    const bf16_t* w1t = (const bf16_t*)(wsl + WS_W + W1_W1T) + (size_t)c * 128 * 4096;
    const bf16_t* w2t = (const bf16_t*)(wsl + WS_W + W1_W2T) + (size_t)c * 128 * 128;
    const float* b1p = (const float*)(wsl + WS_B1P) + c * 128;
    const float* b2 = p.cmp_b2 + (layer * 2 + c) * 128;
    bf16_t* KC = (bf16_t*)(wsl + WS_KC) + ((size_t)c * NBATCH + b) * 128 * 128;
    LAS bf16_t* hid = (LAS bf16_t*)lds;
    const int n = ng * 16 + row, nc = n < 126 ? n : 126;
    const bf16_t* arow = U + (size_t)(b * SEQ + 16 * nc) * U_LD + (c ? UC_VCMP : UC_KCMP) + 8 * k8;
    const bf16_t* brow = w1t + (size_t)(16 * wid + row) * 4096 + 8 * k8;
    f32x4 acc = {0.f, 0.f, 0.f, 0.f};
#pragma unroll 16
    for (int ks = 0; ks < 128; ++ks) {
        const bf16x8 a = *(const bf16x8*)(arow + (size_t)(ks >> 2) * U_LD + (ks & 3) * 32);
        const bf16x8 bb = *(const bf16x8*)(brow + ks * 32);
        acc = __builtin_amdgcn_mfma_f32_16x16x32_bf16(a, bb, acc, 0, 0, 0);
    }
    __syncthreads();
    { const int e = 16 * wid + row; const float bias = b1p[e];
#pragma unroll
      for (int j = 0; j < 4; ++j) hid[(k8 * 4 + j) * 136 + e] = f2bf(gelu_erf(acc[j] + bias)); }
    __syncthreads();
    f32x4 acc2 = {0.f, 0.f, 0.f, 0.f};
#pragma unroll
    for (int ks = 0; ks < 4; ++ks) {
        const bf16x8 a = *(const LAS bf16x8*)(hid + row * 136 + ks * 32 + 8 * k8);
        const bf16x8 bb = *(const bf16x8*)(w2t + (size_t)(16 * wid + row) * 128 + ks * 32 + 8 * k8);
        acc2 = __builtin_amdgcn_mfma_f32_16x16x32_bf16(a, bb, acc2, 0, 0, 0);
    }
    { const int e = 16 * wid + row; const float bias = b2[e];
#pragma unroll
      for (int j = 0; j < 4; ++j) { const int no = ng * 16 + k8 * 4 + j; KC[(size_t)no * 128 + e] = (no < 127) ? f2bf(acc2[j] + bias) : (bf16_t)0; } }
    __syncthreads();
}
constexpr int AT_K = 0, AT_KB = 64 * 272, AT_V = 2 * AT_KB, AT_VB = 128 * 144, AT_KI = AT_V + 2 * AT_VB, AT_LUT = AT_KI + 512, LUT_LD = 2052,
              AT_IMPW = AT_LUT + 4 * LUT_LD * 4, AT_IMPT = AT_IMPW + 32768, AT_MASK = AT_IMPT + 8192, AT_SC = AT_MASK + 256, AT_MISC = AT_SC + 2048, AT_END = AT_MISC + 64;
constexpr int LDS_BYTES = 150528;
static_assert(AT_END <= LDS_BYTES, "lds");
constexpr int BIGD = 1 << 28;

__device__ __forceinline__ int crow(int r, int hi) { return (r & 3) + 8 * (r >> 2) + 4 * hi; }
__device__ __forceinline__ unsigned wave_or(unsigned v) {
#pragma unroll
    for (int off = 32; off >= 1; off >>= 1) v |= (unsigned)__shfl_xor((int)v, off);
    return v; }
struct KVSrc { const bf16_t* k; const bf16_t* v; int ld, tok0, tstride; };
struct KVRegs { bf16x8 k0, k1, v0, v1; float kin; };

template <bool KIN>
__device__ __forceinline__ void kv_issue(KVRegs& R, const KVSrc& s, int kt, const float* cum) {
    const int tid = otid();
    { const int row = tid >> 3, c = (tid & 7) * 16; const bf16_t* kp = s.k + (size_t)(s.tok0 + (kt * 64 + row) * s.tstride) * s.ld + c;
      R.k0 = *(const bf16x8*)kp; R.k1 = *(const bf16x8*)(kp + 8); }
    { const int row = tid & 63, c = (tid >> 6) * 16; const bf16_t* vp = s.v + (size_t)(s.tok0 + (kt * 64 + row) * s.tstride) * s.ld + c;
      R.v0 = *(const bf16x8*)vp; R.v1 = *(const bf16x8*)(vp + 8); }
    if (KIN) { if (tid < 64) R.kin = cum[kt * 64 + tid] * LOG2E; }
}
template <bool KIN>
__device__ __forceinline__ void kv_commit(const KVRegs& R, LAS unsigned char* lds, int buf) {
    const int tid = otid();
    { const int row = tid >> 3, c = (tid & 7) * 16; LAS unsigned char* kp = lds + AT_K + buf * AT_KB + row * 272 + c * 2;
      *(LAS bf16x8*)kp = R.k0; *(LAS bf16x8*)(kp + 16) = R.k1; }
    { const int row = tid & 63, c = (tid >> 6) * 16, pos = (row & ~12) | ((row & 4) << 1) | ((row & 8) >> 1);
      LAS unsigned char* vp = lds + AT_V + buf * AT_VB + c * 144 + pos * 2;
#pragma unroll
      for (int i = 0; i < 8; ++i) { *(LAS short*)(vp + i * 144) = R.v0[i]; *(LAS short*)(vp + (8 + i) * 144) = R.v1[i]; } }
    if (KIN) { if (tid < 64) ((LAS float*)(lds + AT_KI))[buf * 64 + tid] = R.kin; }
}
__device__ __forceinline__ void qk_tile(LAS const unsigned char* kt, int r32, int hi, const bf16x8 (&qr)[8], f32x16& p0, f32x16& p1) {
#pragma unroll
    for (int r = 0; r < 16; ++r) { p0[r] = 0.f; p1[r] = 0.f; }
    LAS const unsigned char* a = kt + r32 * 272 + hi * 16;
    bf16x8 f0[8], f1[8];
#pragma unroll
    for (int d0 = 0; d0 < 8; ++d0) { f0[d0] = *(LAS const bf16x8*)(a + d0 * 32); f1[d0] = *(LAS const bf16x8*)(a + 32 * 272 + d0 * 32); }
    asm volatile("s_waitcnt lgkmcnt(8)" ::: "memory"); __builtin_amdgcn_sched_barrier(0);
    __builtin_amdgcn_s_setprio(1);
#pragma unroll
    for (int d0 = 0; d0 < 4; ++d0) { p0 = __builtin_amdgcn_mfma_f32_32x32x16_bf16(f0[d0], qr[d0], p0, 0, 0, 0); p1 = __builtin_amdgcn_mfma_f32_32x32x16_bf16(f1[d0], qr[d0], p1, 0, 0, 0); }
    __builtin_amdgcn_sched_barrier(0); asm volatile("s_waitcnt lgkmcnt(0)" ::: "memory"); __builtin_amdgcn_sched_barrier(0);
#pragma unroll
    for (int d0 = 4; d0 < 8; ++d0) { p0 = __builtin_amdgcn_mfma_f32_32x32x16_bf16(f0[d0], qr[d0], p0, 0, 0, 0); p1 = __builtin_amdgcn_mfma_f32_32x32x16_bf16(f1[d0], qr[d0], p1, 0, 0, 0); }
    __builtin_amdgcn_s_setprio(0);
}
__device__ __forceinline__ void pv_tile(LAS const unsigned char* vt, int r32, int hi, const bf16x8 (&pa)[4], f32x16 (&o)[4]) {
    LAS const unsigned char* a = vt + r32 * 144 + hi * 16;
    bf16x8 vf[16];
#pragma unroll
    for (int i = 0; i < 16; ++i) vf[i] = *(LAS const bf16x8*)(a + (i >> 2) * 32 * 144 + (i & 3) * 32);
    asm volatile("s_waitcnt lgkmcnt(8)" ::: "memory"); __builtin_amdgcn_sched_barrier(0);
    __builtin_amdgcn_s_setprio(1);
#pragma unroll
    for (int i = 0; i < 8; ++i) o[i >> 2] = __builtin_amdgcn_mfma_f32_32x32x16_bf16(pa[i & 3], vf[i], o[i >> 2], 0, 0, 0);
    __builtin_amdgcn_sched_barrier(0); asm volatile("s_waitcnt lgkmcnt(0)" ::: "memory"); __builtin_amdgcn_sched_barrier(0);
#pragma unroll
    for (int i = 8; i < 16; ++i) o[i >> 2] = __builtin_amdgcn_mfma_f32_32x32x16_bf16(pa[i & 3], vf[i], o[i >> 2], 0, 0, 0);
    __builtin_amdgcn_s_setprio(0);
}
__device__ __forceinline__ void pack_p(const f32x16& p0, const f32x16& p1, bf16x8 (&pa)[4]) {
#pragma unroll
    for (int s = 0; s < 4; ++s) { const f32x16& p = (s < 2) ? p0 : p1; const int r0 = 8 * (s & 1);
        u32x4 w; w.x = cvt_pk_bf16(p[r0], p[r0 + 1]); w.y = cvt_pk_bf16(p[r0 + 2], p[r0 + 3]); w.z = cvt_pk_bf16(p[r0 + 4], p[r0 + 5]); w.w = cvt_pk_bf16(p[r0 + 6], p[r0 + 7]);
        pa[s] = *reinterpret_cast<bf16x8*>(&w); }
}
__device__ __forceinline__ void scale_rows(f32x16 (&o)[4], float f, LAS float* sc, int r32, int hi) {
    sc[r32] = f;
    float fr[16];
#pragma unroll
    for (int r = 0; r < 16; ++r) fr[r] = sc[crow(r, hi)];
#pragma unroll
    for (int d0 = 0; d0 < 4; ++d0)
#pragma unroll
        for (int r = 0; r < 16; ++r) o[d0][r] *= fr[r];
}
constexpr int ST_SLICE = 8704;
static_assert(8 * ST_SLICE <= AT_KI, "staging slices must fit the K/V tile buffers");
template <class RowPtr>
__device__ __forceinline__ void store_rows_bf16(const f32x16 (&o)[4], LAS unsigned char* slice, int lane, RowPtr rp) {
    const int r32 = lane & 31, hi = lane >> 5;
#pragma unroll
    for (int r = 0; r < 16; ++r)
#pragma unroll
        for (int d0 = 0; d0 < 4; ++d0) *(LAS short*)(slice + crow(r, hi) * 272 + (d0 * 32 + r32) * 2) = (short)f2bf(o[d0][r]);
#pragma unroll
    for (int i = 0; i < 8; ++i) { const int c = lane + 64 * i, row = c >> 4, ch = c & 15;
        const u32x4 w = *(LAS const u32x4*)(slice + row * 272 + ch * 16);
        *(u32x4*)(rp(row) + ch * 8) = w; }
}
template <int MODE, class RowF, class RowB>
__device__ __forceinline__ void store_rows_f32(const f32x16 (&o)[4], LAS unsigned char* slice, int lane, RowF rf, RowB rb) {
    const int r32 = lane & 31, hi = lane >> 5;
#pragma unroll
    for (int half = 0; half < 2; ++half) {
#pragma unroll
        for (int rr = 0; rr < 8; ++rr)
#pragma unroll
            for (int d0 = 0; d0 < 4; ++d0) *(LAS float*)(slice + (crow(8 * half + rr, hi) - 16 * half) * 528 + (d0 * 32 + r32) * 4) = o[d0][8 * half + rr];
#pragma unroll
        for (int i = 0; i < 8; ++i) { const int c = lane + 64 * i, rowl = c >> 5, ch = c & 31, row = 16 * half + rowl;
            const f32x4 v = *(LAS const f32x4*)(slice + rowl * 528 + ch * 16);
            if (MODE == 0) *(f32x4*)(rf(row) + ch * 4) = v;
            else if (MODE == 1) { float* q = rf(row) + ch * 4; *(f32x4*)q = *(const f32x4*)q + v; }
            else { const f32x4 t = *(const f32x4*)(rf(row) + ch * 4) + v; u32x2 w; w.x = cvt_pk_bf16(t[0], t[1]); w.y = cvt_pk_bf16(t[2], t[3]); *(u32x2*)(rb(row) + ch * 4) = w; } }
    }
}
template <int TYPE>
__device__ __forceinline__ void attn_pass(LAS unsigned char* lds, const KVSrc& src, unsigned tilemask, const float* cum,
                                          const bf16x8 (&qr)[8], int qi, bool row_valid, int qw_lo, int qw_hi, bool wave_valid, int maxd, int lutmax,
                                          unsigned selmask, float cq, int lutrow, f32x16 (&o)[4], float& m, float& l) {
    const int tid = otid(), wid = tid >> 6, lane = tid & 63, r32 = lane & 31, hi = lane >> 5;
    LAS float* sc = (LAS float*)(lds + AT_SC) + wid * 64;
    LAS const float* lut = (LAS const float*)(lds + AT_LUT) + lutrow * LUT_LD;
    const float NEG = -__builtin_inff();
#pragma unroll
    for (int d0 = 0; d0 < 4; ++d0)
#pragma unroll
        for (int r = 0; r < 16; ++r) o[d0][r] = 0.f;
    m = -1e30f; l = 0.f;
    const unsigned wsel = (TYPE == 2) ? wave_or(selmask) : 0xffffffffu;
    KVRegs R;
    unsigned tm = tilemask;
    int kt = __ffs(tm) - 1; tm &= tm - 1;
    kv_issue<TYPE == 0>(R, src, kt, cum);
    __syncthreads();
    kv_commit<TYPE == 0>(R, lds, 0);
    __syncthreads();
    int buf = 0;
    for (;;) {
        const int nk = tm ? (__ffs(tm) - 1) : -1;
        if (nk >= 0) { tm &= tm - 1; kv_issue<TYPE == 0>(R, src, nk, cum); }
        const bool act = wave_valid && (64 * kt <= qw_hi) && (64 * kt + 63 >= qw_lo - maxd) && ((wsel >> kt) & 1u);
        if (act) {
            f32x16 p0, p1;
            qk_tile(lds + AT_K + buf * AT_KB, r32, hi, qr, p0, p1);
            LAS const float* kin = (LAS const float*)(lds + AT_KI) + buf * 64;
            const bool rok = row_valid && ((TYPE != 2) || ((selmask >> kt) & 1u));
            const bool interior = (TYPE != 2) && (64 * kt + 63 <= qw_lo) && (64 * kt >= qw_hi - maxd);
            const int qb = qi - kt * 64 - 4 * hi;
            constexpr float C2 = ATT_SCALE * LOG2E;
            float mx = NEG;
            if (TYPE == 0) {
#define MOD_HALF(P, H32) _Pragma("unroll") for (int g = 0; g < 4; ++g) { const f32x4 kv = *(LAS const f32x4*)(kin + 32 * (H32) + 4 * hi + 8 * g); \
                _Pragma("unroll") for (int i = 0; i < 4; ++i) { const int r = 4 * g + i; float v = fmaf(P[r], C2, cq - kv[i]); \
                    if (!interior) { const int dq = qb - (32 * (H32) + i + 8 * g); v = (rok && dq >= 0) ? v : NEG; } \
                    P[r] = v; mx = fmaxf(mx, v); } }
                MOD_HALF(p0, 0) MOD_HALF(p1, 1)
#undef MOD_HALF
            } else {
                LAS const float* lq = lut + (qb - 63);
#define MOD_HALF(P, H32) _Pragma("unroll") for (int r = 0; r < 16; ++r) { const int c = 32 * (H32) + (r & 3) + 8 * (r >> 2); \
                    float v = fmaf(P[r], C2, lq[63 - c]); \
                    if (!interior) { const int dq = qb - c; v = (rok && ((unsigned)dq <= (unsigned)maxd)) ? v : NEG; } \
                    P[r] = v; mx = fmaxf(mx, v); }
                MOD_HALF(p0, 0) MOD_HALF(p1, 1)
#undef MOD_HALF
            }
            { const auto rr = __builtin_amdgcn_permlane32_swap(__float_as_uint(mx), __float_as_uint(mx), false, false); mx = fmaxf(__uint_as_float(rr[0]), __uint_as_float(rr[1])); }
            constexpr float THR = 8.0f;
            float mn, alpha; bool resc;
            if (__all(mx - m <= THR)) { mn = m; alpha = 1.0f; resc = false; }
            else { mn = fmaxf(m, mx); alpha = __builtin_amdgcn_exp2f(m - mn); resc = true; }
            float ps = 0.f;
#pragma unroll
            for (int r = 0; r < 16; ++r) { p0[r] = __builtin_amdgcn_exp2f(p0[r] - mn); p1[r] = __builtin_amdgcn_exp2f(p1[r] - mn); ps += p0[r] + p1[r]; }
            { const auto rr = __builtin_amdgcn_permlane32_swap(__float_as_uint(ps), __float_as_uint(ps), false, false); ps = __uint_as_float(rr[0]) + __uint_as_float(rr[1]); }
            l = l * alpha + ps; m = mn;
            if (resc) scale_rows(o, alpha, sc, r32, hi);
            bf16x8 pa[4]; pack_p(p0, p1, pa);
            pv_tile(lds + AT_V + buf * AT_VB, r32, hi, pa, o);
        }
        if (nk < 0) break;
        kv_commit<TYPE == 0>(R, lds, buf ^ 1);
        __syncthreads();
        buf ^= 1; kt = nk;
    }
    __syncthreads();
}
__device__ __forceinline__ void load_q(const bf16_t* qp, int hi, bf16x8 (&qr)[8]) {
#pragma unroll
    for (int d0 = 0; d0 < 8; ++d0) qr[d0] = *(const bf16x8*)(qp + d0 * 16 + hi * 8);
}
__device__ __forceinline__ unsigned bits_range(int lo, int hi) { return (0xffffffffu >> (31 - hi)) & (0xffffffffu << lo); }

__device__ __forceinline__ void fox_item(int b, int h, int qt, const Params& p, LAS unsigned char* lds) {
    char* const wsl = lp(p.ws);
    const int tid = otid(), wid = tid >> 6, lane = tid & 63, r32 = lane & 31, hi = lane >> 5;
    const bf16_t* U = (const bf16_t*)(wsl + WS_RA + RA_U); bf16_t* OALL = (bf16_t*)(wsl + WS_ZX + ZX_OALL);
    const float* cum = (const float*)(wsl + WS_CUM) + (size_t)(b * 6 + h) * SEQ;
    const int t0 = qt * 256, qi = t0 + wid * 32 + r32;
    bf16x8 qr[8]; load_q(U + (size_t)(b * SEQ + qi) * U_LD + UC_CQ + h * 128, hi, qr);
    KVSrc src; src.k = U + UC_CK + h * 128; src.v = U + UC_CV + h * 128; src.ld = U_LD; src.tok0 = b * SEQ; src.tstride = 1;
    f32x16 o[4]; float m, l;
    attn_pass<0>(lds, src, bits_range(0, 4 * qt + 3), cum, qr, qi, true, t0 + wid * 32, t0 + wid * 32 + 31, true, BIGD, 0, 0u, cum[qi] * LOG2E, 0, o, m, l);
    LAS float* sc = (LAS float*)(lds + AT_SC) + wid * 64;
    scale_rows(o, 1.0f / l, sc, r32, hi);
    { bf16_t* ob = lv(OALL + (size_t)(b * SEQ + t0 + wid * 32) * OA_LD + 768 + h * 128);
      store_rows_bf16(o, lds + AT_K + wid * ST_SLICE, lane, [&](int row) { return ob + (size_t)row * OA_LD; }); }
}
__device__ __forceinline__ void dil_item(int g, int b, int hh, int res, int it, const Params& p, LAS unsigned char* lds) {
    char* const wsl = lp(p.ws);
    const int tid = otid(), wid = tid >> 6, lane = tid & 63, r32 = lane & 31, hi = lane >> 5;
    const bf16_t* U = (const bf16_t*)(wsl + WS_RA + RA_U);
    float* OAP = (float*)(wsl + WS_ZX + ZX_OAP) + (size_t)g * T_TOK * 256; float* LSE = (float*)(wsl + WS_LSE) + (size_t)g * T_TOK * 2;
    const int dil = g == 0 ? 1 : (g == 1 ? 4 : 16), L = SEQ / dil, head = 2 * g + hh, i0 = it * 256, nrows = (L - i0) < 256 ? (L - i0) : 256;
    LAS float* lut = (LAS float*)(lds + AT_LUT);
    if (tid <= 128) lut[tid] = ((const float*)(wsl + WS_BLA))[head * 132 + tid];
    const int slot = wid * 32 + r32; const bool rv = slot < nrows; const int qi = i0 + (rv ? slot : 0);
    bf16x8 qr[8]; load_q(U + (size_t)(b * SEQ + res + dil * qi) * U_LD + UC_AQ + head * 128, hi, qr);
    KVSrc src; src.k = U + UC_AK + head * 128; src.v = U + UC_AV + head * 128; src.ld = U_LD; src.tok0 = b * SEQ + res; src.tstride = dil;
    const int klo = (i0 - 128) > 0 ? (i0 - 128) : 0, khi = ((i0 + 256) < L ? (i0 + 256) : L) - 1;
    f32x16 o[4]; float m, l;
    __syncthreads();
    attn_pass<1>(lds, src, bits_range(klo >> 6, khi >> 6), nullptr, qr, qi, rv, i0 + wid * 32, i0 + wid * 32 + 31, wid * 32 < nrows, 128, 128, 0u, 0.f, 0, o, m, l);
    LAS float* sc = (LAS float*)(lds + AT_SC) + wid * 64;
    scale_rows(o, rv ? 1.0f / l : 0.f, sc, r32, hi);
    if (wid * 32 < nrows) {
        if (hi == 0 && rv) LSE[(size_t)(b * SEQ + res + dil * qi) * 2 + hh] = (m + log2f(l)) * LN2;
        float* ob = lv(OAP + (size_t)(b * SEQ + res + dil * (i0 + wid * 32)) * 256 + hh * 128);
        store_rows_f32<0>(o, lds + AT_K + wid * ST_SLICE, lane, [&](int row) { return ob + (size_t)row * dil * 256; }, [&](int) { return (bf16_t*)nullptr; });
    }
}
__device__ __forceinline__ void mergeA_item(int item, const Params& p) {
    char* const wsl = lp(p.ws);
    const int tid = otid(), tok = item * 256 + (tid >> 1), hh = tid & 1;
    const float* OAP = (const float*)(wsl + WS_ZX + ZX_OAP); const float* LSE = (const float*)(wsl + WS_LSE); bf16_t* OALL = (bf16_t*)(wsl + WS_ZX + ZX_OALL);
    const float l0 = LSE[(size_t)tok * 2 + hh], l1 = LSE[(size_t)(T_TOK + tok) * 2 + hh], l2 = LSE[(size_t)(2 * T_TOK + tok) * 2 + hh];
    const float mx = fmaxf(l0, fmaxf(l1, l2)), e0 = __expf(l0 - mx), e1 = __expf(l1 - mx), e2 = __expf(l2 - mx), inv = 1.0f / (e0 + e1 + e2);
    const float w0 = e0 * inv, w1 = e1 * inv, w2 = e2 * inv;
    const float* a0 = OAP + (size_t)tok * 256 + hh * 128; const float* a1 = a0 + (size_t)T_TOK * 256; const float* a2 = a1 + (size_t)T_TOK * 256;
    bf16_t* op = OALL + (size_t)tok * OA_LD + hh * 128;
#pragma unroll 4
    for (int d = 0; d < 128; d += 4) { const f32x4 v = *(const f32x4*)(a0 + d) * w0 + *(const f32x4*)(a1 + d) * w1 + *(const f32x4*)(a2 + d) * w2;
        u32x2 w; w.x = cvt_pk_bf16(v[0], v[1]); w.y = cvt_pk_bf16(v[2], v[3]); *(u32x2*)(op + d) = w; }
}
__device__ __forceinline__ void nsa_item(int b, int tt, const Params& p, int layer, LAS unsigned char* lds) {
    char* const wsl = lp(p.ws);
    const int tid = otid(), wid = tid >> 6, lane = tid & 63, r32 = lane & 31, hi = lane >> 5;
    const bf16_t* U = (const bf16_t*)(wsl + WS_RA + RA_U); bf16_t* OALL = (bf16_t*)(wsl + WS_ZX + ZX_OALL); float* OBT = (float*)(wsl + WS_ZX + ZX_OBT);
    const float* S = (const float*)(wsl + WS_S); const bf16_t* KC = (const bf16_t*)(wsl + WS_KC);
    const int head = wid >> 1, t0 = tt * 64, tl = (wid & 1) * 32 + r32, qi = t0 + tl, row = b * SEQ + qi;
    LAS float* lutall = (LAS float*)(lds + AT_LUT);
    { const float* blb = (const float*)(wsl + WS_BLB);
#pragma unroll 4
      for (int i = tid; i < 4 * LUT_LD; i += 512) lutall[i] = blb[i]; }
    bf16x8 qr[8]; load_q(U + (size_t)row * U_LD + UC_BQ + head * 128, hi, qr);
    const float* bg = p.b_nsa_gate + layer * 12;
    const float g0 = sigmoidf_(S[(size_t)row * 32 + head] + bg[head]), g1 = sigmoidf_(S[(size_t)row * 32 + 4 + head] + bg[4 + head]), g2 = sigmoidf_(S[(size_t)row * 32 + 8 + head] + bg[8 + head]);
    LAS float* sc = (LAS float*)(lds + AT_SC) + wid * 64;
    LAS const float* lut = lutall + head * LUT_LD;
    f32x16 o[4];
    { KVSrc src; src.k = KC + (size_t)b * 128 * 128; src.v = KC + (size_t)(NBATCH + b) * 128 * 128; src.ld = 128; src.tok0 = 0; src.tstride = 1;
      KVRegs R; kv_issue<false>(R, src, 0, nullptr); kv_commit<false>(R, lds, 0); kv_issue<false>(R, src, 1, nullptr); kv_commit<false>(R, lds, 1); }
    __syncthreads();
    {
        f32x16 pa0, pa1, pb0, pb1;
        qk_tile(lds + AT_K, r32, hi, qr, pa0, pa1); qk_tile(lds + AT_K + AT_KB, r32, hi, qr, pb0, pb1);
        const float NEG = -__builtin_inff(); float mx = NEG;
#define CMP_MOD(P, Q4) _Pragma("unroll") for (int r = 0; r < 16; ++r) { \
                const int n = 32 * (Q4) + crow(r, hi), dc = qi - (16 * n + 31); \
                const bool ok = dc >= 0 && n < 127; \
                const float s = fmaf(P[r], ATT_SCALE * LOG2E, lut[dc < 0 ? 0 : dc]); \
                const float v = ok ? s : NEG; P[r] = v; mx = fmaxf(mx, v); }
        CMP_MOD(pa0, 0) CMP_MOD(pa1, 1) CMP_MOD(pb0, 2) CMP_MOD(pb1, 3)
#undef CMP_MOD
        mx = fmaxf(mx, __shfl_xor(mx, 32));
        float ps = 0.f;
#pragma unroll
        for (int r = 0; r < 16; ++r) {
            pa0[r] = (pa0[r] == NEG) ? 0.f : __builtin_amdgcn_exp2f(pa0[r] - mx); pa1[r] = (pa1[r] == NEG) ? 0.f : __builtin_amdgcn_exp2f(pa1[r] - mx);
            pb0[r] = (pb0[r] == NEG) ? 0.f : __builtin_amdgcn_exp2f(pb0[r] - mx); pb1[r] = (pb1[r] == NEG) ? 0.f : __builtin_amdgcn_exp2f(pb1[r] - mx);
            ps += (pa0[r] + pa1[r]) + (pb0[r] + pb1[r]); }
        ps += __shfl_xor(ps, 32);
        const float inv = ps > 0.f ? 1.0f / ps : 0.f;
        {
            float mainv[16], extra[16];
#pragma unroll
            for (int idx = 0; idx < 16; ++idx) { const int q4 = idx >> 2, gq = idx & 3;
                const f32x16& pp = (q4 == 0) ? pa0 : (q4 == 1) ? pa1 : (q4 == 2) ? pb0 : pb1;
                mainv[idx] = ((pp[4 * gq] + pp[4 * gq + 1]) + (pp[4 * gq + 2] + pp[4 * gq + 3])) * inv; extra[idx] = pp[4 * gq + 3] * inv; }
            LAS float* impw = (LAS float*)(lds + AT_IMPW) + (wid * 32 + r32) * 32;
#pragma unroll
            for (int idx = 0; idx < 16; ++idx) { const float eo = __shfl_xor(extra[idx], 32); const float eprev = (idx > 0) ? __shfl_xor(extra[idx > 0 ? idx - 1 : 0], 32) : 0.f;
                impw[2 * idx + hi] = mainv[idx] + (hi ? eo : eprev); }
        }
        bf16x8 pkA[4], pkB[4];
        pack_p(pa0, pa1, pkA); pack_p(pb0, pb1, pkB);
        asm volatile("" ::: "memory");
#pragma unroll
        for (int d0 = 0; d0 < 4; ++d0)
#pragma unroll
            for (int r = 0; r < 16; ++r) o[d0][r] = 0.f;
        pv_tile(lds + AT_V, r32, hi, pkA, o);
        pv_tile(lds + AT_V + AT_VB, r32, hi, pkB, o);
        scale_rows(o, g0 * inv, sc, r32, hi);
        { float* ob = lv(OBT + (size_t)(b * SEQ + t0 + (wid & 1) * 32 + 4 * hi) * 512 + head * 128 + r32);
#pragma unroll
        for (int r = 0; r < 16; ++r) { float* op = ob + ((r & 3) + 8 * (r >> 2)) * 512;
#pragma unroll
            for (int d0 = 0; d0 < 4; ++d0) op[d0 * 32] = o[d0][r]; } }
    }
    __syncthreads();
    { const int tk = tid >> 3, jq = tid & 7; LAS const float* iw = (LAS const float*)(lds + AT_IMPW); LAS float* it = (LAS float*)(lds + AT_IMPT);
#pragma unroll
      for (int e = 0; e < 4; ++e) { const int j = 4 * jq + e; float s = 0.f;
#pragma unroll
          for (int h = 0; h < 4; ++h) s += iw[((2 * h + (tk >> 5)) * 32 + (tk & 31)) * 32 + j];
          it[tk * 32 + j] = s; } }
    __syncthreads();
    { const int tk = tid >> 3, jq = tid & 7; LAS const float* it = (LAS const float*)(lds + AT_IMPT) + tk * 32;
      float scv[32];
#pragma unroll
      for (int j = 0; j < 32; ++j) scv[j] = (j == 0 || j == tt || j == tt - 1) ? 1e9f : (j <= tt ? it[j] : -1e30f);
      unsigned bits = 0;
#pragma unroll
      for (int e = 0; e < 4; ++e) { const int j = 4 * jq + e; float sj = scv[0];
#pragma unroll
          for (int i = 1; i < 32; ++i) sj = (i == j) ? scv[i] : sj;
          int rank = 0;
#pragma unroll
          for (int i = 0; i < 32; ++i) rank += (scv[i] > sj || (scv[i] == sj && i < j)) ? 1 : 0;
          if (rank < 16) bits |= 1u << j; }
      bits |= (unsigned)__shfl_xor((int)bits, 1); bits |= (unsigned)__shfl_xor((int)bits, 2); bits |= (unsigned)__shfl_xor((int)bits, 4);
      if (jq == 0) ((LAS unsigned*)(lds + AT_MASK))[tk] = bits; }
    __syncthreads();
    const unsigned selmask = ((LAS const unsigned*)(lds + AT_MASK))[tl];
    const unsigned allsel = wave_or(((LAS const unsigned*)(lds + AT_MASK))[lane]);
    float m, l;
    { KVSrc src; src.k = U + UC_KSLC; src.v = U + UC_VSLC; src.ld = U_LD; src.tok0 = b * SEQ; src.tstride = 1;
      attn_pass<2>(lds, src, allsel & bits_range(0, tt), nullptr, qr, qi, true, t0 + (wid & 1) * 32, t0 + (wid & 1) * 32 + 31, true, BIGD, 2048, selmask, 0.f, head, o, m, l);
      scale_rows(o, g1 / l, sc, r32, hi);
      float* ob = lv(OBT + (size_t)(b * SEQ + t0 + (wid & 1) * 32) * 512 + head * 128);
      store_rows_f32<1>(o, lds + AT_K + wid * ST_SLICE, lane, [&](int row) { return ob + (size_t)row * 512; }, [&](int) { return (bf16_t*)nullptr; }); }
    { KVSrc src; src.k = U + UC_KWIN; src.v = U + UC_VWIN; src.ld = U_LD; src.tok0 = b * SEQ; src.tstride = 1;
      attn_pass<3>(lds, src, bits_range(tt > 8 ? tt - 8 : 0, tt), nullptr, qr, qi, true, t0 + (wid & 1) * 32, t0 + (wid & 1) * 32 + 31, true, 511, 511, 0u, 0.f, head, o, m, l);
      scale_rows(o, g2 / l, sc, r32, hi);
      float* tb = lv(OBT + (size_t)(b * SEQ + t0 + (wid & 1) * 32) * 512 + head * 128);
      bf16_t* obb = lv(OALL + (size_t)(b * SEQ + t0 + (wid & 1) * 32) * OA_LD + 256 + head * 128);
      store_rows_f32<2>(o, lds + AT_K + wid * ST_SLICE, lane, [&](int row) { return tb + (size_t)row * 512; }, [&](int row) { return obb + (size_t)row * OA_LD; }); }
}
__device__ __forceinline__ int next_item(unsigned* ctr, LAS unsigned char* lds) {
    LAS int* slot = (LAS int*)(lds + AT_MISC);
    __syncthreads();
    if (threadIdx.x == 0) *slot = (int)atomicAdd(ctr, 1u);
    __syncthreads();
    return *slot;
}
#ifndef LOCKSTEP
#define LOCKSTEP 0
#endif
template <class Epi>
__device__ __forceinline__ void run_gemm(LAS unsigned char* lds, const bf16_t* A, int lda, const bf16_t* Bt, int ldb, int N, int K, const Epi& E, unsigned* lockstep = nullptr) {
    pg8::Gemm g; g.A = lp(A); g.Bt = lp(Bt); g.M = T_TOK; g.N = li(N); g.K = li(K); g.lda = li(lda); g.ldb = li(ldb); N = g.N;
    pg8::StaticOrder S; S.init(T_TOK, N, gridDim.x, blockIdx.x, Epi::NSEG);
    pg8::gemm_phase<Epi>(lds, g, S, E, lockstep);
}

#define ws (lp(p.ws))
#define XB ((bf16_t*)(ws + WS_XB))
#define ZX ((float*)(ws + WS_ZX))
#define Ubuf ((bf16_t*)(ws + WS_RA + RA_U))
#define Gbuf ((bf16_t*)(ws + WS_RA + RA_G))
#define Hbuf ((bf16_t*)(ws + WS_RA + RA_H))
#define ACT ((bf16_t*)(ws + WS_RA + RA_ACT))
#define Sbuf ((float*)(ws + WS_S))
#define ctr ((unsigned*)(ws + WS_CTR))
#define SYNC() xcd_barrier(xb)
template <int layer>
__device__ __forceinline__ void layer_body(const Params& p, LAS unsigned char* lds, const XcdBarrier& xb) {
    const int wid = otid() >> 6;
        const float* xin = layer == 0 ? p.x : p.out;
        { pg8::Epi1 E; E.U = Ubuf; E.G = Gbuf; E.S = Sbuf; E.b_gate = p.b_gate + (size_t)layer * 6144;
          run_gemm(lds, XB, KLD, (const bf16_t*)(ws + WS_W + W1_BT1), KLD, N1, DM, E, LOCKSTEP ? ctr + 8 + layer * 4 : nullptr); }
        SYNC();
        for (;;) { const int i = next_item(ctr + (layer * 2 + 0) * 64, lds); if (i >= 646) break;
            if (i < 128) cmp_mlp_unit(i, p, layer, lds);
            else if (i < 134) { cumsum_task((i - 128) * 8 + wid, Sbuf, p.b_f + layer * 6, (float*)(ws + WS_CUM), lds); }
            else if (i < 262) { const int j = i - 134; dil_item(0, j >> 4, (j >> 3) & 1, 0, j & 7, p, lds); }
            else if (i < 390) { const int j = i - 262; dil_item(1, j >> 4, (j >> 3) & 1, (j >> 1) & 3, j & 1, p, lds); }
            else { const int j = i - 390; dil_item(2, j >> 5, (j >> 4) & 1, j & 15, 0, p, lds); } }
        SYNC();
        for (;;) { const int i = next_item(ctr + (layer * 2 + 1) * 64, lds); if (i >= 704) break;
            if (i < 640) {
                int fox_qt = -1, fox_w = 0, nsa_tt = 0, nsa_b = 0;
                if (i < 160) { nsa_tt = 31 - (i >> 3); nsa_b = i & 7; }
                else if (i < 352) { const int j = i - 160; fox_qt = 7 - j / 48; fox_w = j % 48; }
                else if (i < 384) { const int j = i - 352; nsa_tt = 11 - (j >> 3); nsa_b = j & 7; }
                else if (i < 432) { fox_qt = 3; fox_w = i - 384; }
                else if (i < 464) { const int j = i - 432; nsa_tt = 7 - (j >> 3); nsa_b = j & 7; }
                else if (i < 560) { const int j = i - 464; fox_qt = 2 - j / 48; fox_w = j % 48; }
                else if (i < 592) { const int j = i - 560; nsa_tt = 3 - (j >> 3); nsa_b = j & 7; }
                else { fox_qt = 0; fox_w = i - 592; }
                if (fox_qt >= 0) fox_item(fox_w / 6, fox_w % 6, fox_qt, p, lds);
                else nsa_item(nsa_b, nsa_tt, p, layer, lds); }
            else mergeA_item(i - 640, p); }
        SYNC();
        { pg8::Epi2 E; E.G = Gbuf; E.O = XB; E.T = (bf16_t*)(ws + WS_RA + RA_U);
          run_gemm(lds, (const bf16_t*)(ws + WS_ZX + ZX_OALL), OA_LD, (const bf16_t*)(ws + WS_W + W1_BTP), OA_LD, DM, OA_LD, E); }
        SYNC();
        { pg8::EpiRes E; E.R = xin; E.Z = ZX;
          run_gemm(lds, XB, KLD, (const bf16_t*)(ws + WS_W + W1_BTOUT), KLD, DM, DM, E); }
        SYNC();
        ln_phase<true>(ZX, ZX, XB, p.ln1_g + (size_t)layer * DM, p.ln1_b + (size_t)layer * DM);
        convert_phase(p, layer, 2, lds);

        SYNC();
        { pg8::EpiH E; E.H = Hbuf; E.ldh = 2 * FFA;
          run_gemm(lds, XB, KLD, (const bf16_t*)(ws + WS_W + W2_BTUP), KLD, 2 * FFA, DM, E, LOCKSTEP ? ctr + 9 + layer * 4 : nullptr); }
        SYNC();
        conv_phase(Hbuf, FFA, 0, p.conv_w + (size_t)layer * 3 * 2 * DFF, p.conv_b + (size_t)layer * 2 * DFF, ACT);
        SYNC();
        { pg8::EpiH E; E.H = Hbuf; E.ldh = 2 * FFB;
          run_gemm(lds, XB, KLD, (const bf16_t*)(ws + WS_W + W2_BTUP) + (size_t)2 * FFA * KLD, KLD, 2 * FFB, DM, E, LOCKSTEP ? ctr + 10 + layer * 4 : nullptr); }
        SYNC();
        conv_phase(Hbuf, FFB, FFA, p.conv_w + (size_t)layer * 3 * 2 * DFF, p.conv_b + (size_t)layer * 2 * DFF, ACT);
        SYNC();
        { pg8::EpiRes E; E.R = ZX; E.Z = ZX;
          run_gemm(lds, ACT, DFF, (const bf16_t*)(ws + WS_W + W2_BTDN), DFF, DM, DFF, E); }
        SYNC();
        ln_phase<(layer + 1 < NLAYER)>(ZX, p.out, XB, p.ln2_g + (size_t)layer * DM, p.ln2_b + (size_t)layer * DM);
        if (layer + 1 < NLAYER) { convert_phase(p, layer + 1, 1, lds); b1p_phase(p, layer + 1); SYNC(); }
}
__global__ void __launch_bounds__(512, 2) hybrid_fwd(Params p) {
    extern __shared__ __attribute__((aligned(16))) unsigned char lds_raw[];
    LAS unsigned char* lds = (LAS unsigned char*)lds_raw;
    cg::grid_group grid = cg::this_grid();
    if (threadIdx.x == 0) { ((LAS unsigned*)(lds + AT_MISC))[4] = 0u; ((LAS unsigned*)(lds + AT_MISC))[5] = 0u; }
    __syncthreads();
    const XcdBarrier xb = xcd_barrier_post((unsigned*)(ws + WS_BAR), (volatile LAS unsigned*)(lds + AT_MISC + 16));
    convert_phase(p, 0, 1, lds); b1p_phase(p, 0); bucket_phase(p); xcvt_phase(p.x, XB);
    if (p.never) grid.sync();
    SYNC();
    layer_body<0>(p, lds, xb);
    layer_body<1>(p, lds, xb);
}
#undef ws
#undef XB
#undef ZX
#undef Ubuf
#undef Gbuf
#undef Hbuf
#undef ACT
#undef Sbuf
#undef ctr
#undef SYNC

extern "C" void kernel_launch(void* const* d_in, const int* in_sizes, int n_in, void* d_out, int out_size, void* d_ws, size_t ws_size, hipStream_t stream) {
    static int grid_blocks = 0;
    if (!grid_blocks) {
        int dev = 0, cus = 0, per_cu = 0;
        (void)hipGetDevice(&dev);
        (void)hipDeviceGetAttribute(&cus, hipDeviceAttributeMultiprocessorCount, dev);
        if (hipFuncSetAttribute((const void*)hybrid_fwd, hipFuncAttributeMaxDynamicSharedMemorySize, LDS_BYTES) != hipSuccess) fprintf(stderr, "hipFuncSetAttribute failed\n");
        (void)hipOccupancyMaxActiveBlocksPerMultiprocessor(&per_cu, hybrid_fwd, 512, LDS_BYTES);
        if (per_cu < 1) per_cu = 1;
        if (cus <= 0) cus = 256;
        grid_blocks = cus * per_cu;
        fprintf(stderr, "grid %d (cus %d per_cu %d) ws %zu need %zu\n", grid_blocks, cus, per_cu, ws_size, (size_t)WS_TOTAL);
    }
    if (ws_size < WS_TOTAL || n_in < 24) { fprintf(stderr, "workspace too small / bad inputs\n"); return; }
    Params p{};
    const float* const* in = (const float* const*)d_in;
    p.x = in[0]; p.rel_bias = in[1]; p.w_in = in[2]; p.b_f = in[3]; p.b_nsa_gate = in[4]; p.cmp_pe = in[5]; p.cmp_w1 = in[6]; p.cmp_b1 = in[7];
    p.cmp_w2 = in[8]; p.cmp_b2 = in[9]; p.w_gate = in[10]; p.b_gate = in[11]; p.w_pa = in[12]; p.w_pb = in[13]; p.w_pc = in[14]; p.w_out = in[15];
    p.ln1_g = in[16]; p.ln1_b = in[17]; p.w_up = in[18]; p.conv_w = in[19]; p.conv_b = in[20]; p.w_down = in[21]; p.ln2_g = in[22]; p.ln2_b = in[23];
    p.out = (float*)d_out; p.ws = (char*)d_ws; p.never = 0; p.pad = 0;
    (void)hipMemsetAsync((char*)d_ws + WS_CTR, 0, 1024 + 16384, stream);
    void* args[] = {&p};
    hipError_t e = hipLaunchCooperativeKernel((void*)hybrid_fwd, dim3(grid_blocks), dim3(512), args, LDS_BYTES, stream);
    if (e != hipSuccess) fprintf(stderr, "cooperative launch failed: %s (grid %d)\n", hipGetErrorString(e), grid_blocks);
}
```
